# Optimizing an MI355X kernel written in HIP

```python
import math
import jax, jax.numpy as jnp
from jax import lax
import numpy as np

D_MODEL = 2048
BATCH = 2
SEQ = 4096
DEPTH = 1
DEC_BATCH = 8
DEC_SEQ = 1
PAST_LEN = 16384
PAGE_SIZE = 128

D_A = D_MODEL // 2
HEAD_DIM_A = 64
N_HEADS_A = D_A // HEAD_DIM_A
DECAY_LORA = 64
AAA_LORA = 64
D_B = D_MODEL // 2
HEAD_DIM_B = 128
N_HEADS_B = D_B // HEAD_DIM_B
ROT_DIM = HEAD_DIM_B // 4
ROPE_THETA = 500000.0
MOBA_BLOCK = 256
MOBA_TOPK = 3
Q_CHUNK = 32
RW_COLS = 4 * D_A + DECAY_LORA + AAA_LORA
N_IN = RW_COLS + 4 * D_B + 2 * D_MODEL
NORM_EPS = 1e-6
GN_EPS = 64e-5
NEG = -1e30

kernel_name = "rwkv7_moba_gated_hybrid_step"


def rmsnorm(x, w):
    xf = x.astype(jnp.float32)
    y = xf * lax.rsqrt(jnp.mean(xf * xf, axis=-1, keepdims=True) + NORM_EPS)
    return (y * w.astype(jnp.float32)).astype(x.dtype)


def partial_rope(x, pos):
    half = ROT_DIM // 2
    inv = jnp.power(jnp.float32(ROPE_THETA), -jnp.arange(half, dtype=jnp.float32) * (2.0 / ROT_DIM))
    ang = pos.astype(jnp.float32)[:, None] * inv[None, :]
    cos = jnp.cos(ang)[None, :, None, :]
    sin = jnp.sin(ang)[None, :, None, :]
    xf = x.astype(jnp.float32)
    x1 = xf[..., :half]
    x2 = xf[..., half:ROT_DIM]
    out = jnp.concatenate([x1 * cos - x2 * sin, x2 * cos + x1 * sin, xf[..., ROT_DIM:]], axis=-1)
    return out.astype(x.dtype)


def wkv7_scan(s0, r, w, k, v, kk, a):
    def step(S, inp):
        r_t, w_t, k_t, v_t, kk_t, a_t = inp
        sa = jnp.einsum('bhij,bhj->bhi', S, -kk_t)
        S = (S * w_t[:, :, None, :]
             + sa[..., None] * (kk_t * a_t)[:, :, None, :]
             + v_t[..., None] * k_t[:, :, None, :])
        y = jnp.einsum('bhij,bhj->bhi', S, r_t)
        return S, y
    xs = tuple(jnp.moveaxis(t, 1, 0) for t in (r, w, k, v, kk, a))
    S, ys = lax.scan(step, s0, xs)
    return jnp.moveaxis(ys, 0, 1), S


def rwkv7_branch(z_rw, z_prev0, s0, mu, w0, w2, a0, a2, k_k, k_a, r_k, lnx_w, lnx_b):
    f32 = jnp.float32
    B, T, _ = z_rw.shape
    z_prev = jnp.concatenate([z_prev0[:, None, :], z_rw[:, :-1, :]], axis=1)
    zm = z_rw + (z_prev - z_rw) * mu
    cuts = np.cumsum([D_A, DECAY_LORA, D_A, D_A, AAA_LORA]).tolist()
    r, w_lo, k, v, a_lo, g = jnp.split(zm, cuts, axis=-1)
    w_log = -jax.nn.softplus(-(w0 + jnp.tanh(w_lo) @ w2).astype(f32)) - 0.5
    decay = jnp.exp(-jnp.exp(w_log))
    a = jax.nn.sigmoid((a0 + a_lo @ a2).astype(f32))
    hs = lambda t: t.astype(f32).reshape(B, T, N_HEADS_A, HEAD_DIM_A)
    kf = hs(k)
    kk = kf * k_k.astype(f32).reshape(N_HEADS_A, HEAD_DIM_A)
    kk = kk / jnp.maximum(jnp.sqrt(jnp.sum(kk * kk, axis=-1, keepdims=True)), 1e-12)
    ah = a.reshape(B, T, N_HEADS_A, HEAD_DIM_A)
    kf = kf * (1.0 + (ah - 1.0) * k_a.astype(f32).reshape(N_HEADS_A, HEAD_DIM_A))
    rf = hs(r)
    vf = hs(v)
    y, S = wkv7_scan(s0.astype(f32), rf, decay.reshape(B, T, N_HEADS_A, HEAD_DIM_A), kf, vf, kk, ah)
    mean = jnp.mean(y, axis=-1, keepdims=True)
    var = jnp.mean(jnp.square(y - mean), axis=-1, keepdims=True)
    yn = ((y - mean) * lax.rsqrt(var + GN_EPS)).reshape(B, T, D_A)
    yn = yn * lnx_w.astype(f32) + lnx_b.astype(f32)
    bonus = jnp.sum(rf * kf * r_k.astype(f32), axis=-1, keepdims=True) * vf
    out = (yn + bonus.reshape(B, T, D_A)) * jax.nn.silu(g.astype(f32))
    return out.astype(z_rw.dtype), S


def moba_attention(q, k_past, k_new, v_past, v_new, q_offset):
    f32 = jnp.float32
    B, Tq, H, hd = q.shape
    L = k_past.shape[1] + Tq
    nb = -(-L // MOBA_BLOCK)
    pad = nb * MOBA_BLOCK - L
    zpad = jnp.zeros((B, pad, H, hd), k_new.dtype)
    kb = jnp.concatenate([k_past, k_new, zpad], axis=1).reshape(B, nb, MOBA_BLOCK, H, hd)
    vb = jnp.concatenate([v_past, v_new, zpad.astype(v_new.dtype)], axis=1).reshape(B, nb, MOBA_BLOCK, H, hd)
    kmean = jnp.mean(kb.astype(f32), axis=2)
    qh = q.transpose(0, 2, 1, 3)
    qpos = q_offset + jnp.arange(Tq)
    qblk = qpos // MOBA_BLOCK
    gate = jnp.einsum('bhtd,bnhd->bhtn', qh.astype(f32), kmean)
    gate = jnp.where(jnp.arange(nb)[None, :] < qblk[:, None], gate, NEG)
    n_sel = min(MOBA_TOPK, nb)
    _, sel = lax.top_k(gate, n_sel)
    valid = sel < qblk[None, None, :, None]
    qc = math.gcd(Q_CHUNK, Tq)
    n_ch = Tq // qc

    def chunks(t):
        return t.reshape(B, H, n_ch, qc, t.shape[-1]).transpose(2, 0, 1, 3, 4)

    starts = q_offset + jnp.arange(n_ch) * qc
    bidx = jnp.arange(B)[:, None, None, None]
    hidx = jnp.arange(H)[None, :, None, None]
    scale = hd ** -0.5

    def step(args):
        qi, si, vi, t0 = args
        blk = t0 // MOBA_BLOCK
        kg = kb[bidx, si, :, hidx, :]
        vg = vb[bidx, si, :, hidx, :]
        ko = lax.dynamic_index_in_dim(kb, blk, axis=1, keepdims=False)
        vo = lax.dynamic_index_in_dim(vb, blk, axis=1, keepdims=False)
        s_sel = jnp.einsum('bhqd,bhqnkd->bhqnk', qi, kg).astype(f32) * scale
        s_sel = jnp.where(vi[..., None], s_sel, NEG)
        qp = t0 + jnp.arange(qc)
        kp = blk * MOBA_BLOCK + jnp.arange(MOBA_BLOCK)
        s_own = jnp.einsum('bhqd,bkhd->bhqk', qi, ko).astype(f32) * scale
        s_own = jnp.where(kp[None, :] <= qp[:, None], s_own, NEG)
        s = jnp.concatenate([s_sel.reshape(B, H, qc, n_sel * MOBA_BLOCK), s_own], axis=-1)
        p = jax.nn.softmax(s, axis=-1).astype(vb.dtype)
        p_sel = p[..., :n_sel * MOBA_BLOCK].reshape(B, H, qc, n_sel, MOBA_BLOCK)
        p_own = p[..., n_sel * MOBA_BLOCK:]
        return (jnp.einsum('bhqnk,bhqnkd->bhqd', p_sel, vg)
                + jnp.einsum('bhqk,bkhd->bhqd', p_own, vo))

    out = lax.map(step, (chunks(qh), chunks(sel), chunks(valid), starts))
    return out.transpose(1, 0, 3, 2, 4).reshape(B, Tq, H, hd)


def hybrid_layer(h, pos, q_offset, shift, s0, k_past, v_past,
                 ln_w, w_in, mu, w0, w2, a0, a2, k_k, k_a, r_k, lnx_w, lnx_b, p_a, p_b, w_o):
    B, T, _ = h.shape
    xn = rmsnorm(h, ln_w)
    z = xn @ w_in
    z_rw = z[..., :RW_COLS]
    z_prev0 = shift.astype(xn.dtype) @ w_in[:, :RW_COLS]
    o_a, s_new = rwkv7_branch(z_rw, z_prev0, s0, mu, w0, w2, a0, a2, k_k, k_a, r_k, lnx_w, lnx_b)
    zq, zk, zv, zg_b = jnp.split(z[..., RW_COLS:RW_COLS + 4 * D_B], 4, axis=-1)
    z_gates = z[..., RW_COLS + 4 * D_B:]
    q = partial_rope(zq.reshape(B, T, N_HEADS_B, HEAD_DIM_B), pos)
    k = partial_rope(zk.reshape(B, T, N_HEADS_B, HEAD_DIM_B), pos)
    v = zv.reshape(B, T, N_HEADS_B, HEAD_DIM_B)
    attn = moba_attention(q, k_past.astype(k.dtype), k, v_past.astype(v.dtype), v, q_offset)
    o_b = attn.reshape(B, T, D_B) * jax.nn.silu(zg_b)
    gate_a = jax.nn.sigmoid(z_gates[..., :D_MODEL].astype(jnp.float32)).astype(h.dtype)
    gate_b = jax.nn.sigmoid(z_gates[..., D_MODEL:].astype(jnp.float32)).astype(h.dtype)
    merged = gate_a * (o_a @ p_a) + gate_b * (o_b @ p_b)
    h = h + merged @ w_o
    return h, xn[:, -1, :], s_new, k, v


def setup_inputs(seed: int = 0) -> dict:
    key = jax.random.key(seed)
    ks = jax.random.split(key, 24)
    f32 = jnp.float32
    nrm = lambda k, shape, s: jax.random.normal(k, shape, f32) * s
    n_pages = PAST_LEN // PAGE_SIZE
    n_used = DEC_BATCH * n_pages
    n_pool = n_used + max(1, n_used // 4)
    page_table = jax.random.permutation(ks[6], n_pool)[:n_used].reshape(DEC_BATCH, n_pages).astype(jnp.int32)
    return {
        "x_prompt": nrm(ks[0], (BATCH, SEQ, D_MODEL), 1.0),
        "x_sample": nrm(ks[1], (DEC_BATCH, DEC_SEQ, D_MODEL), 1.0),
        "state_shift": nrm(ks[2], (DEPTH, DEC_BATCH, D_MODEL), 1.0),
        "state_wkv": nrm(ks[3], (DEPTH, DEC_BATCH, N_HEADS_A, HEAD_DIM_A, HEAD_DIM_A), 0.3),
        "cache_k": nrm(ks[4], (DEPTH, n_pool, PAGE_SIZE, N_HEADS_B, HEAD_DIM_B), 1.0),
        "cache_v": nrm(ks[5], (DEPTH, n_pool, PAGE_SIZE, N_HEADS_B, HEAD_DIM_B), 1.0),
        "page_table": page_table,
        "ln_w": 1.0 + nrm(ks[7], (DEPTH, D_MODEL), 0.02),
        "w_in": nrm(ks[8], (DEPTH, D_MODEL, N_IN), D_MODEL ** -0.5),
        "mu": jax.random.uniform(ks[9], (DEPTH, RW_COLS), f32),
        "w0": nrm(ks[10], (DEPTH, D_A), 0.5) - 0.5,
        "w2": nrm(ks[11], (DEPTH, DECAY_LORA, D_A), DECAY_LORA ** -0.5),
        "a0": nrm(ks[12], (DEPTH, D_A), 0.1),
        "a2": nrm(ks[13], (DEPTH, AAA_LORA, D_A), AAA_LORA ** -0.5),
        "k_k": 0.85 + nrm(ks[14], (DEPTH, D_A), 0.02),
        "k_a": 1.0 + nrm(ks[15], (DEPTH, D_A), 0.02),
        "r_k": nrm(ks[16], (DEPTH, N_HEADS_A, HEAD_DIM_A), 0.1),
        "lnx_w": 1.0 + nrm(ks[17], (DEPTH, D_A), 0.02),
        "lnx_b": nrm(ks[18], (DEPTH, D_A), 0.02),
        "p_a": nrm(ks[19], (DEPTH, D_A, D_MODEL), D_A ** -0.5),
        "p_b": nrm(ks[20], (DEPTH, D_B, D_MODEL), D_B ** -0.5),
        "w_o": nrm(ks[21], (DEPTH, D_MODEL, D_MODEL), D_MODEL ** -0.5),
        "final_w": 1.0 + nrm(ks[22], (D_MODEL,), 0.02),
    }


def reference(x_prompt, x_sample, state_shift, state_wkv, cache_k, cache_v, page_table,
              ln_w, w_in, mu, w0, w2, a0, a2, k_k, k_a, r_k, lnx_w, lnx_b, p_a, p_b, w_o, final_w):
    B, T, _ = x_prompt.shape
    DB, TS, _ = x_sample.shape
    n_pages = page_table.shape[1]
    past = n_pages * cache_k.shape[2]
    pos_p = jnp.arange(T)
    pos_s = past + jnp.arange(TS)
    hp, hs = x_prompt, x_sample
    sh_p, wk_p, kp_l, vp_l = [], [], [], []
    sh_s, wk_s, ks_l, vs_l = [], [], [], []
    for l in range(DEPTH):
        lw = (ln_w[l], w_in[l], mu[l], w0[l], w2[l], a0[l], a2[l], k_k[l], k_a[l], r_k[l],
              lnx_w[l], lnx_b[l], p_a[l], p_b[l], w_o[l])
        empty = jnp.zeros((B, 0, N_HEADS_B, HEAD_DIM_B), x_prompt.dtype)
        hp, s1, s2, s3, s4 = hybrid_layer(
            hp, pos_p, 0, jnp.zeros((B, D_MODEL), x_prompt.dtype),
            jnp.zeros((B, N_HEADS_A, HEAD_DIM_A, HEAD_DIM_A), jnp.float32), empty, empty, *lw)
        sh_p.append(s1.astype(state_shift.dtype))
        wk_p.append(s2.astype(state_wkv.dtype))
        kp_l.append(s3.astype(cache_k.dtype))
        vp_l.append(s4.astype(cache_v.dtype))
        k_past = cache_k[l][page_table].reshape(DB, past, N_HEADS_B, HEAD_DIM_B)
        v_past = cache_v[l][page_table].reshape(DB, past, N_HEADS_B, HEAD_DIM_B)
        hs, t1, t2, t3, t4 = hybrid_layer(
            hs, pos_s, past, state_shift[l], state_wkv[l], k_past, v_past, *lw)
        sh_s.append(t1.astype(state_shift.dtype))
        wk_s.append(t2.astype(state_wkv.dtype))
        ks_l.append(t3.astype(cache_k.dtype))
        vs_l.append(t4.astype(cache_v.dtype))
    y_prompt = rmsnorm(hp, final_w)
    y_sample = rmsnorm(hs, final_w)
    shift_prompt = jnp.stack(sh_p)
    wkv_prompt = jnp.stack(wk_p)
    k_prompt = jnp.stack(kp_l)
    v_prompt = jnp.stack(vp_l)
    shift_sample = jnp.stack(sh_s)
    wkv_sample = jnp.stack(wk_s)
    k_sample = jnp.stack(ks_l)
    v_sample = jnp.stack(vs_l)
    return (y_prompt, y_sample, shift_prompt, wkv_prompt, k_prompt, v_prompt,
            shift_sample, wkv_sample, k_sample, v_sample)
```

```cpp
#include <hip/hip_runtime.h>
#include <cstdio>
#include <cstdint>

#define GAS __attribute__((address_space(1)))
#define LAS __attribute__((address_space(3)))
typedef unsigned short bf16_t;
typedef short bf16x8 __attribute__((ext_vector_type(8)));
typedef short s16x4 __attribute__((ext_vector_type(4)));
typedef float f32x2 __attribute__((ext_vector_type(2)));
typedef float f32x4 __attribute__((ext_vector_type(4)));
typedef float f32x16 __attribute__((ext_vector_type(16)));
typedef unsigned u32x2 __attribute__((ext_vector_type(2)));
typedef unsigned u32x4 __attribute__((ext_vector_type(4)));

constexpr int DM = 2048, NBATCH = 2, TSEQ = 4096, MP = NBATCH * TSEQ;
constexpr int DECB = 8, PAST = 16384, PAGE = 128, NPG = PAST / PAGE;
constexpr int DA = 1024, HA = 16, NA = 64;
constexpr int DBB = 1024, HB = 8, HD = 128;
constexpr int NIN = 12416, ZLD = 12544;
constexpr int RWC = 4224;
constexpr int ZC_R = 0, ZC_K = 1024, ZC_V = 2048, ZC_G = 3072, ZC_Q = 4096, ZC_KB = 5120, ZC_VB = 6144, ZC_GB = 7168, ZC_GATE = 8192, ZC_WLO = 12288, ZC_ALO = 12352;
constexpr size_t O_YP = 0, O_YS = 16777216, O_SHP = O_YS + 16384, O_WKP = O_SHP + 4096, O_KP = O_WKP + 131072, O_VP = O_KP + 8388608,
                 O_SHS = O_VP + 8388608, O_WKS = O_SHS + 16384, O_KS = O_WKS + 524288, O_VS = O_KS + 8192, O_END = O_VS + 8192;
constexpr float NORM_EPS = 1e-6f, GN_EPS = 64e-5f;

__host__ __device__ inline int zcol_to_src(int c) {
    if (c < 1024) return c;
    if (c < 2048) return 1088 + (c - 1024);
    if (c < 3072) return 2112 + (c - 2048);
    if (c < 4096) return 3200 + (c - 3072);
    if (c < 8192) return 4224 + (c - 4096);
    if (c < 12288) return 8320 + (c - 8192);
    if (c < 12352) return 1024 + (c - 12288);
    if (c < 12416) return 3136 + (c - 12352);
    return -1;
}

__host__ __device__ inline int perm32inv(int c) { return 16 * ((c >> 2) & 1) + 4 * (c >> 3) + (c & 3); }
__host__ __device__ inline int wrow(int c) { const int l = c & 255; return (c & ~255) + 128 * ((l >> 5) & 1) + 32 * (l >> 6) + perm32inv(l & 31); }
__host__ __device__ inline int wrow_in(int c) { return c < 12288 ? wrow(c) : c; }

__device__ __forceinline__ unsigned cvt_pk_bf16(float lo, float hi) { unsigned r; asm volatile("v_cvt_pk_bf16_f32 %0, %1, %2" : "=v"(r) : "v"(lo), "v"(hi)); return r; }
__device__ __forceinline__ float bf2f(unsigned short b) { return __uint_as_float(((unsigned)b) << 16); }
__device__ __forceinline__ float bflo(unsigned w) { return __uint_as_float(w << 16); }
__device__ __forceinline__ float bfhi(unsigned w) { return __uint_as_float(w & 0xffff0000u); }
__device__ __forceinline__ float sigmoidf_(float x) { return __builtin_amdgcn_rcpf(1.0f + __builtin_amdgcn_exp2f(-1.4426950408889634f * x)); }
__device__ __forceinline__ float siluf_(float x) { return x * sigmoidf_(x); }
__device__ __forceinline__ float wave_sum(float v) {
#pragma unroll
    for (int o = 1; o < 64; o <<= 1) v += __shfl_xor(v, o);
    return v;
}
__device__ __forceinline__ float wave_max(float v) {
#pragma unroll
    for (int o = 1; o < 64; o <<= 1) v = fmaxf(v, __shfl_xor(v, o));
    return v;
}
__device__ __forceinline__ void mfma_fence4(f32x4& v) { asm volatile("s_nop 7\n\ts_nop 7" : "+v"(v)); }
#define LDS_WAIT() asm volatile("s_waitcnt lgkmcnt(0)" ::: "memory")
#define VM_WAIT() asm volatile("s_waitcnt vmcnt(0)" ::: "memory")
__device__ __forceinline__ void ld8bf(const bf16_t* p, float (&o)[8]) {
    const u32x4 w = *(const u32x4*)p;
    o[0] = bflo(w.x); o[1] = bfhi(w.x); o[2] = bflo(w.y); o[3] = bfhi(w.y); o[4] = bflo(w.z); o[5] = bfhi(w.z); o[6] = bflo(w.w); o[7] = bfhi(w.w);
}
__device__ __forceinline__ void ld8bf_lds(const LAS bf16_t* p, float (&o)[8]) {
    const u32x4 w = *(const LAS u32x4*)p;
    o[0] = bflo(w.x); o[1] = bfhi(w.x); o[2] = bflo(w.y); o[3] = bfhi(w.y); o[4] = bflo(w.z); o[5] = bfhi(w.z); o[6] = bflo(w.w); o[7] = bfhi(w.w);
}
__device__ __forceinline__ void ld8f(const float* p, float (&o)[8]) {
    const f32x4 a = *(const f32x4*)p, b = *(const f32x4*)(p + 4);
    o[0] = a.x; o[1] = a.y; o[2] = a.z; o[3] = a.w; o[4] = b.x; o[5] = b.y; o[6] = b.z; o[7] = b.w;
}
__device__ __forceinline__ void ld8f_lds(const LAS float* p, float (&o)[8]) {
    const f32x4 a = *(const LAS f32x4*)p, b = *(const LAS f32x4*)(p + 4);
    o[0] = a.x; o[1] = a.y; o[2] = a.z; o[3] = a.w; o[4] = b.x; o[5] = b.y; o[6] = b.z; o[7] = b.w;
}
__device__ __forceinline__ void st8f(float* p, const float (&o)[8]) {
    *(f32x4*)p = (f32x4){o[0], o[1], o[2], o[3]}; *(f32x4*)(p + 4) = (f32x4){o[4], o[5], o[6], o[7]};
}
namespace pg8 {
#define PG8_LAS __attribute__((address_space(3)))
typedef unsigned short bf16_t;
typedef short bf16x8 __attribute__((ext_vector_type(8)));
typedef float f32x4 __attribute__((ext_vector_type(4)));
typedef unsigned u32x4 __attribute__((ext_vector_type(4)));
constexpr int BM = 256, BK = 64, HALF = 128, HTB = HALF * BK * 2  , STAGE_BYTES = 8 * HTB, NXCD = 8, WGM = 8;

__host__ __device__ __forceinline__ int lds_byte(int r, int c) { const int st = (r >> 4) * 2 + (c >> 5), rr = r & 15, cc = c & 31, ob = rr * 64 + cc * 2; return st * 1024 + (ob ^ (((ob >> 9) & 1) << 5)); }
__host__ __device__ __forceinline__ void stage_rc(int b, int& R, int& C) { const int st = b / 1024, sb = b % 1024, swz = sb ^ (((sb >> 9) & 1) << 5); R = (st >> 1) * 16 + swz / 64; C = (st & 1) * 32 + (swz % 64) / 2; }
__host__ __device__ __forceinline__ int perm32(int rho) { const int n = rho >> 4, i = rho & 15; return 8 * (i >> 2) + 4 * n + (i & 3); }

struct Unit { int pm, pn; };
struct Gemm { const bf16_t* A; const bf16_t* Bt; int M, N, K; };

struct StaticOrder {
    int nM, nN, nwg, G, c;
    __host__ __device__ void init(int M, int N, int G_, int c_) { nM = M / BM; nN = N / BM; nwg = nM * nN; G = G_; c = c_; }
    __host__ __device__ bool next(int i, Unit& u) const {
        const long L = (long)i * G + c; if (L >= nwg) return false;
        int wgid = (int)L; { const int q = nwg / NXCD, r = nwg % NXCD, xcd = wgid % NXCD, off = wgid / NXCD; wgid = (xcd < r ? xcd * (q + 1) : r * (q + 1) + (xcd - r) * q) + off; }
        const int nig = WGM * nN, gid = wgid / nig, fm = gid * WGM, gsz = (nM - fm) < WGM ? (nM - fm) : WGM;
        u.pm = fm + ((wgid % nig) % gsz); u.pn = (wgid % nig) / gsz; return true;
    }
    __device__ __forceinline__ void a_ready(const Unit&) const {}
    __device__ __forceinline__ void done(const Unit&) const {}
};
__device__ __forceinline__ u32x4 pk8(f32x4 a, f32x4 b) { u32x4 w; w.x = cvt_pk_bf16(a[0], a[1]); w.y = cvt_pk_bf16(a[2], a[3]); w.z = cvt_pk_bf16(b[0], b[1]); w.w = cvt_pk_bf16(b[2], b[3]); return w; }
struct EpiIn {
    static constexpr bool PERM = false, AFTER_DRAIN = false;
    bf16_t* Z; float* kout; float* vout; float* kmp; const float* rope;
    __device__ __forceinline__ void operator()(const f32x4 (&acc)[2][2][4][2], const Unit& u, int wr, int wc, int fr, int fq) const {
        const int pn = u.pn, row0 = u.pm * BM + wr * 64 + fr, col0 = pn * BM + wc * 64 + 8 * fq;
        const bool is_rope = (pn >= 16 && pn < 24) && ((wc & 1) == 0);
        const bool is_k = (pn >= 20 && pn < 24), is_v = (pn >= 24 && pn < 28), is_silu = (pn >= 28 && pn < 32), is_sig = (pn >= 32 && pn < 48);
        float* fout = is_k ? kout : vout; const int fcol0 = (pn - (is_k ? 20 : 24)) * BM + wc * 64 + 8 * fq;
        const float rsgn = (fq < 2) ? -1.0f : 1.0f;
        f32x4 ks[2][2];
#pragma unroll
        for (int bj = 0; bj < 2; ++bj)
#pragma unroll
            for (int n = 0; n < 2; ++n) ks[bj][n] = (f32x4){0.f, 0.f, 0.f, 0.f};
#pragma unroll
        for (int ai = 0; ai < 2; ++ai)
#pragma unroll
            for (int m = 0; m < 4; ++m) {
                const int row = row0 + ai * HALF + m * 16;
                bf16_t* zrow = Z + (size_t)row * ZLD + col0;
#pragma unroll
                for (int bj = 0; bj < 2; ++bj) {
                    f32x4 v0 = acc[ai][bj][m][0], v1 = acc[ai][bj][m][1];
                    if (bj == 0 && is_rope) {
                        const float* rp = rope + (size_t)(row & 4095) * 32 + 8 * (fq & 1);
                        const f32x4 c0 = *(const f32x4*)rp, c1 = *(const f32x4*)(rp + 4), s0 = *(const f32x4*)(rp + 16), s1 = *(const f32x4*)(rp + 20);
                        f32x4 o0, o1;
#pragma unroll
                        for (int j = 0; j < 4; ++j) { o0[j] = __shfl_xor(v0[j], 32); o1[j] = __shfl_xor(v1[j], 32); }
                        v0 = v0 * c0 + o0 * s0 * rsgn; v1 = v1 * c1 + o1 * s1 * rsgn;
                    }
                    if (is_silu) {
#pragma unroll
                        for (int j = 0; j < 4; ++j) { v0[j] = siluf_(v0[j]); v1[j] = siluf_(v1[j]); } }
                    if (is_sig) {
#pragma unroll
                        for (int j = 0; j < 4; ++j) { v0[j] = sigmoidf_(v0[j]); v1[j] = sigmoidf_(v1[j]); } }
                    *(u32x4*)(zrow + bj * 32) = pk8(v0, v1);
                    if (is_k || is_v) { float* fp = fout + (size_t)row * 1024 + fcol0 + bj * 32; *(f32x4*)fp = v0; *(f32x4*)(fp + 4) = v1; }
                    if (is_k) { ks[bj][0] += v0; ks[bj][1] += v1; }
                }
            }
        if (is_k) {
#pragma unroll
            for (int bj = 0; bj < 2; ++bj)
#pragma unroll
                for (int n = 0; n < 2; ++n) {
                    f32x4 s = ks[bj][n];
#pragma unroll
                    for (int o = 1; o < 16; o <<= 1) { s[0] += __shfl_xor(s[0], o); s[1] += __shfl_xor(s[1], o); s[2] += __shfl_xor(s[2], o); s[3] += __shfl_xor(s[3], o); }
                    if (fr == 0) *(f32x4*)(kmp + (size_t)(u.pm * 2 + wr) * 1024 + fcol0 + bj * 32 + n * 4) = s;
                }
        }
    }
};
struct EpiMrgA {
    static constexpr bool PERM = false, AFTER_DRAIN = false;
    const bf16_t* Z; float* tmp;
    __device__ __forceinline__ void operator()(const f32x4 (&acc)[2][2][4][2], const Unit& u, int wr, int wc, int fr, int fq) const {
        const int row0 = u.pm * BM + wr * 64 + fr, col0 = u.pn * BM + wc * 64 + 8 * fq;
#pragma unroll
        for (int ai = 0; ai < 2; ++ai)
#pragma unroll
            for (int m = 0; m < 4; ++m) { const int row = row0 + ai * HALF + m * 16; const bf16_t* gp = Z + (size_t)row * ZLD + ZC_GATE + col0; float* tp = tmp + (size_t)row * DM + col0;
#pragma unroll
                for (int bj = 0; bj < 2; ++bj) { const u32x4 g = *(const u32x4*)(gp + bj * 32); const f32x4 a = acc[ai][bj][m][0], b = acc[ai][bj][m][1];
                    *(f32x4*)(tp + bj * 32) = (f32x4){a[0] * bflo(g.x), a[1] * bfhi(g.x), a[2] * bflo(g.y), a[3] * bfhi(g.y)};
                    *(f32x4*)(tp + bj * 32 + 4) = (f32x4){b[0] * bflo(g.z), b[1] * bfhi(g.z), b[2] * bflo(g.w), b[3] * bfhi(g.w)}; } }
    }
};
struct EpiMrgB {
    static constexpr bool PERM = false, AFTER_DRAIN = false;
    const bf16_t* Z; const float* tmp; bf16_t* mrg;
    __device__ __forceinline__ void operator()(const f32x4 (&acc)[2][2][4][2], const Unit& u, int wr, int wc, int fr, int fq) const {
        const int row0 = u.pm * BM + wr * 64 + fr, col0 = u.pn * BM + wc * 64 + 8 * fq;
#pragma unroll
        for (int ai = 0; ai < 2; ++ai)
#pragma unroll
            for (int m = 0; m < 4; ++m) { const int row = row0 + ai * HALF + m * 16; const bf16_t* gp = Z + (size_t)row * ZLD + ZC_GATE + DM + col0; const float* tp = tmp + (size_t)row * DM + col0;
                bf16_t* op = mrg + (size_t)row * DM + col0;
#pragma unroll
                for (int bj = 0; bj < 2; ++bj) { const u32x4 g = *(const u32x4*)(gp + bj * 32); const f32x4 a = acc[ai][bj][m][0], b = acc[ai][bj][m][1];
                    const f32x4 t0 = *(const f32x4*)(tp + bj * 32), t1 = *(const f32x4*)(tp + bj * 32 + 4);
                    const f32x4 r0 = (f32x4){t0[0] + a[0] * bflo(g.x), t0[1] + a[1] * bfhi(g.x), t0[2] + a[2] * bflo(g.y), t0[3] + a[3] * bfhi(g.y)};
                    const f32x4 r1 = (f32x4){t1[0] + b[0] * bflo(g.z), t1[1] + b[1] * bfhi(g.z), t1[2] + b[2] * bflo(g.w), t1[3] + b[3] * bfhi(g.w)};
                    *(u32x4*)(op + bj * 32) = pk8(r0, r1); } }
    }
};
struct EpiRes {
    static constexpr bool PERM = false, AFTER_DRAIN = false;
    const float* x; float* out;
    __device__ __forceinline__ void operator()(const f32x4 (&acc)[2][2][4][2], const Unit& u, int wr, int wc, int fr, int fq) const {
        const int row0 = u.pm * BM + wr * 64 + fr, col0 = u.pn * BM + wc * 64 + 8 * fq;
#pragma unroll
        for (int ai = 0; ai < 2; ++ai)
#pragma unroll
            for (int m = 0; m < 4; ++m) { const size_t off = (size_t)(row0 + ai * HALF + m * 16) * DM + col0;
#pragma unroll
                for (int bj = 0; bj < 2; ++bj) { *(f32x4*)(out + off + bj * 32) = *(const f32x4*)(x + off + bj * 32) + acc[ai][bj][m][0]; *(f32x4*)(out + off + bj * 32 + 4) = *(const f32x4*)(x + off + bj * 32 + 4) + acc[ai][bj][m][1]; } }
    }
};
template <class Epi, class Sched, bool ALIGN_EPI = false, bool SP2 = false>
__device__ __forceinline__ void gemm_phase(PG8_LAS unsigned char* lds, const Gemm g, const Sched& S, const Epi& E) {
    const int tid = threadIdx.x, wid = __builtin_amdgcn_readfirstlane(tid >> 6), lane = tid & 63, wr = wid >> 2, wc = wid & 3, fr = lane & 15, fq = lane >> 4;
    const int K = g.K, nt = K / BK;
    unsigned voffA[2], voffB[2];
#pragma unroll
    for (int i = 0; i < 2; ++i) { int R, C; stage_rc(tid * 16 + i * 8192, R, C); const int Rb = Epi::PERM ? ((R & ~31) + perm32(R & 31)) : R;
        voffA[i] = (unsigned)(R * K + C) * 2u; voffB[i] = (unsigned)(Rb * K + C) * 2u; }
    const size_t kstep = (size_t)(BK * 2);
    const size_t hstep = (size_t)HALF * K * 2;
    const size_t tstep = 2 * hstep;
    const unsigned ldsw = (unsigned)wid * 1024u;
    const int aoff = lds_byte(wr * 64 + fr, fq * 8), boff = lds_byte(wc * 32 + fr, fq * 8);
#define PG8_SA(b, h) (((b) * 2 + (h)) * HTB)
#define PG8_SB(b, h) ((4 + (b) * 2 + (h)) * HTB)
#define PG8_STAGE(bufoff, gbase, voff) do { _Pragma("unroll") for (int _i = 0; _i < 2; ++_i) \
        __builtin_amdgcn_global_load_lds((const unsigned*)((const char*)(gbase) + (voff)[_i]), (PG8_LAS unsigned*)(lds + (bufoff) + ldsw + _i * 8192), 16, 0, 0); } while (0)
#define PG8_LDA(dst, b, h) do { _Pragma("unroll") for (int m = 0; m < 4; ++m) _Pragma("unroll") for (int k = 0; k < 2; ++k) dst[m][k] = *(const PG8_LAS bf16x8*)(lds + PG8_SA(b, h) + aoff + m * 2048 + k * 1024); } while (0)
#define PG8_LDB(dst, b, h) do { _Pragma("unroll") for (int n = 0; n < 2; ++n) _Pragma("unroll") for (int k = 0; k < 2; ++k) dst[n][k] = *(const PG8_LAS bf16x8*)(lds + PG8_SB(b, h) + boff + n * 2048 + k * 1024); } while (0)
#define PG8_MMA(ai, bj, At, Bt) do { __builtin_amdgcn_s_setprio(1); _Pragma("unroll") for (int m = 0; m < 4; ++m) _Pragma("unroll") for (int n = 0; n < 2; ++n) _Pragma("unroll") for (int k = 0; k < 2; ++k) \
        acc[ai][bj][m][n] = __builtin_amdgcn_mfma_f32_16x16x32_bf16(Bt[n][k], At[m][k], acc[ai][bj][m][n], 0, 0, 0); __builtin_amdgcn_s_setprio(0); } while (0)
#define PG8_WAIT_V(n) asm volatile("s_waitcnt vmcnt(" #n ")" ::: "memory")
#define PG8_WAIT_L(n) asm volatile("s_waitcnt lgkmcnt(" #n ")" ::: "memory")
#define PG8_BAR __builtin_amdgcn_s_barrier()
#define PG8_SCHED __builtin_amdgcn_sched_barrier(0)
    Unit cur, nxt; int ui = 0;
    if (!S.next(0, cur)) return;
    f32x4 acc[2][2][4][2];
#pragma unroll
    for (int a = 0; a < 2; ++a)
#pragma unroll
        for (int b = 0; b < 2; ++b)
#pragma unroll
            for (int m = 0; m < 4; ++m)
#pragma unroll
                for (int n = 0; n < 2; ++n) acc[a][b][m][n] = (f32x4){0.f, 0.f, 0.f, 0.f};
    bf16x8 At[4][2], B0[2][2], B1[2][2];
    const char* cA = (const char*)g.A + (size_t)cur.pm * tstep; const char* cB = (const char*)g.Bt + (size_t)cur.pn * tstep;
    S.a_ready(cur);
    if constexpr (SP2) {
        PG8_STAGE(PG8_SB(0, 0), cB, voffB); PG8_STAGE(PG8_SB(0, 1), cB + hstep, voffB); PG8_STAGE(PG8_SA(0, 0), cA, voffA); PG8_STAGE(PG8_SA(0, 1), cA + hstep, voffA);
        if (wr == 1) PG8_BAR;
        PG8_WAIT_V(2); PG8_BAR;
        PG8_STAGE(PG8_SB(1, 0), cB + kstep, voffB); PG8_STAGE(PG8_SA(1, 0), cA + kstep, voffA); PG8_STAGE(PG8_SB(1, 1), cB + hstep + kstep, voffB);
        PG8_WAIT_V(6); PG8_BAR;
    } else {
        PG8_STAGE(PG8_SB(0, 0), cB, voffB); PG8_STAGE(PG8_SA(0, 0), cA, voffA); PG8_STAGE(PG8_SB(0, 1), cB + hstep, voffB); PG8_STAGE(PG8_SA(0, 1), cA + hstep, voffA);
        if (wr == 1) PG8_BAR;
        PG8_WAIT_V(4); PG8_BAR;
        PG8_STAGE(PG8_SB(1, 0), cB + kstep, voffB); PG8_STAGE(PG8_SA(1, 0), cA + kstep, voffA); PG8_STAGE(PG8_SB(1, 1), cB + hstep + kstep, voffB);
        PG8_WAIT_V(6); PG8_BAR;
    }
    for (;;) {
        const bool has_next = S.next(ui + 1, nxt);
        const char* nA = has_next ? (const char*)g.A + (size_t)nxt.pm * tstep : cA; const char* nB = has_next ? (const char*)g.Bt + (size_t)nxt.pn * tstep : cB;
        for (int t = 0; t < nt; t += 2) {
            const bool last = (t == nt - 2);
            const char* a1 = cA + (size_t)(t + 1) * kstep;
            const char* a2 = last ? nA : cA + (size_t)(t + 2) * kstep; const char* b2 = last ? nB : cB + (size_t)(t + 2) * kstep;
            const char* a3 = a2 + kstep; const char* b3 = b2 + kstep;
            if (last && has_next) S.a_ready(nxt);
            if constexpr (SP2) {
            PG8_LDB(B0, 0, 0); PG8_LDB(B1, 0, 1); PG8_SCHED; PG8_LDA(At, 0, 0); PG8_STAGE(PG8_SA(1, 1), a1 + hstep, voffA);
            PG8_WAIT_V(8); PG8_WAIT_L(0); PG8_BAR; PG8_MMA(0, 0, At, B0); PG8_MMA(0, 1, At, B1); PG8_BAR; PG8_SCHED;
            PG8_LDA(At, 0, 1); PG8_STAGE(PG8_SB(0, 0), b2, voffB); PG8_STAGE(PG8_SB(0, 1), b2 + hstep, voffB); PG8_STAGE(PG8_SA(0, 0), a2, voffA);
            PG8_WAIT_V(8); PG8_WAIT_L(0); PG8_BAR; PG8_MMA(1, 0, At, B0); PG8_MMA(1, 1, At, B1); PG8_BAR; PG8_SCHED;
            PG8_LDB(B0, 1, 0); PG8_LDB(B1, 1, 1); PG8_SCHED; PG8_LDA(At, 1, 0); PG8_STAGE(PG8_SA(0, 1), a2 + hstep, voffA);
            PG8_WAIT_V(8); PG8_WAIT_L(0); PG8_BAR; PG8_MMA(0, 0, At, B0); PG8_MMA(0, 1, At, B1); PG8_BAR; PG8_SCHED;
            PG8_LDA(At, 1, 1); PG8_STAGE(PG8_SB(1, 0), b3, voffB); PG8_STAGE(PG8_SB(1, 1), b3 + hstep, voffB); PG8_STAGE(PG8_SA(1, 0), a3, voffA);
            PG8_WAIT_V(8); PG8_WAIT_L(0); PG8_BAR; PG8_MMA(1, 0, At, B0); PG8_MMA(1, 1, At, B1); PG8_BAR; PG8_SCHED;
            } else {
            PG8_LDB(B0, 0, 0); PG8_SCHED; PG8_LDA(At, 0, 0); PG8_STAGE(PG8_SA(1, 1), a1 + hstep, voffA);
            PG8_WAIT_L(8); PG8_BAR; PG8_WAIT_L(0); PG8_MMA(0, 0, At, B0); PG8_BAR; PG8_SCHED;
            PG8_LDB(B1, 0, 1); PG8_STAGE(PG8_SB(0, 0), b2, voffB);
            PG8_BAR; PG8_WAIT_L(0); PG8_MMA(0, 1, At, B1); PG8_BAR;
            PG8_LDA(At, 0, 1); PG8_STAGE(PG8_SA(0, 0), a2, voffA);
            PG8_BAR; PG8_WAIT_L(0); PG8_MMA(1, 0, At, B0); PG8_BAR; PG8_SCHED;
            PG8_STAGE(PG8_SB(0, 1), b2 + hstep, voffB);
            PG8_WAIT_V(6); PG8_BAR; PG8_MMA(1, 1, At, B1); PG8_BAR;
            PG8_LDB(B0, 1, 0); PG8_SCHED; PG8_LDA(At, 1, 0); PG8_STAGE(PG8_SA(0, 1), a2 + hstep, voffA);
            PG8_WAIT_L(8); PG8_BAR; PG8_WAIT_L(0); PG8_MMA(0, 0, At, B0); PG8_BAR; PG8_SCHED;
            PG8_LDB(B1, 1, 1); PG8_STAGE(PG8_SB(1, 0), b3, voffB);
            PG8_BAR; PG8_WAIT_L(0); PG8_MMA(0, 1, At, B1); PG8_BAR;
            PG8_LDA(At, 1, 1); PG8_STAGE(PG8_SA(1, 0), a3, voffA);
            PG8_BAR; PG8_WAIT_L(0); PG8_MMA(1, 0, At, B0); PG8_BAR; PG8_SCHED;
            PG8_STAGE(PG8_SB(1, 1), b3 + hstep, voffB);
            PG8_WAIT_V(6); PG8_BAR; PG8_MMA(1, 1, At, B1); PG8_BAR;
            }
        }
        if constexpr (ALIGN_EPI) { if (wr == 0) PG8_BAR; }
        if constexpr (!Epi::AFTER_DRAIN) { E(acc, cur, wr, wc, fr, fq); S.done(cur); }
        if (!has_next) break;
#pragma unroll
        for (int a = 0; a < 2; ++a)
#pragma unroll
            for (int b = 0; b < 2; ++b)
#pragma unroll
                for (int m = 0; m < 4; ++m)
#pragma unroll
                    for (int n = 0; n < 2; ++n) acc[a][b][m][n] = (f32x4){0.f, 0.f, 0.f, 0.f};
        cur = nxt; cA = nA; cB = nB; ++ui;
        if constexpr (ALIGN_EPI) { if (wr == 1) PG8_BAR; }
    }
    PG8_WAIT_V(0);
    if constexpr (!ALIGN_EPI) { if (wr == 0) PG8_BAR; }
    PG8_BAR;
    if constexpr (Epi::AFTER_DRAIN) { E.fused(acc, cur, wr, wc, fr, fq, lds, wid, lane); S.done(cur); }
#undef PG8_SA
#undef PG8_SB
#undef PG8_STAGE
#undef PG8_LDA
#undef PG8_LDB
#undef PG8_MMA
#undef PG8_WAIT_V
#undef PG8_WAIT_L
#undef PG8_BAR
#undef PG8_SCHED
}

}
namespace att {
constexpr int D = 128;
constexpr float SCALE = 0.08838834764831845f;
constexpr float THR = 8.f;
constexpr int NW = 8, QBLK = 32, KVBLK = 64, QB = NW * QBLK;
constexpr int SHM_V = KVBLK * D * 2, SHM_K = KVBLK * D * 2;
constexpr int ATT_LDS = 2 * SHM_V + 2 * SHM_K + NW * 64 * 4;
#define KSWZ(row, colB) ((row) * 256 + ((colB) ^ (((row) & 7) << 4)))
#define SBAR() __builtin_amdgcn_sched_barrier(0)
__device__ __forceinline__ int v_st(int k, int c) { const int kk = (k & ~0xC) | ((k & 4) << 1) | ((k & 8) >> 1); return ((kk >> 3) * 4 + (c >> 5)) * 512 + ((kk & 7) * 32 + (c & 31)) * 2; }
__device__ __forceinline__ int v_rd_base(int lane) { return ((lane & 3) << 3) | (((lane >> 2) & 3) << 6) | (((lane >> 4) & 1) << 5) | (((lane >> 5) & 1) << 8); }
constexpr int v_rd_off(int d0, int ks, int half) { return d0 * 512 + ks * 4096 + half * 2048; }
__device__ __forceinline__ int crow(int r, int hi) { return (r & 3) + 8 * (r >> 2) + 4 * hi; }
__device__ __forceinline__ unsigned cvtpk(float lo, float hi) { unsigned r; asm volatile("v_cvt_pk_bf16_f32 %0, %1, %2" : "=v"(r) : "v"(lo), "v"(hi)); return r; }
__device__ __forceinline__ bf16x8 ld8(const bf16_t* p) { return *reinterpret_cast<const bf16x8*>(p); }
__device__ __forceinline__ void mask_causal(f32x16& p0, f32x16& p1, int dq) {
    const float NEG = -__builtin_inff();
#pragma unroll
    for (int r = 0; r < 16; ++r) {
        const int c = (r & 3) + 8 * (r >> 2);
        if (dq - c < 0) p0[r] = NEG;
        if (dq - c - 32 < 0) p1[r] = NEG;
    }
}
__device__ __forceinline__ void mask_all(f32x16& p0, f32x16& p1, bool keep) {
    const float NEG = -__builtin_inff();
#pragma unroll
    for (int r = 0; r < 16; ++r) { p0[r] = keep ? p0[r] : NEG; p1[r] = keep ? p1[r] : NEG; }
}
__device__ __forceinline__ void partialSM(f32x16& p0, f32x16& p1, float& m_reg, float& mn, float& alpha) {
    float pmax = p0[0];
#pragma unroll
    for (int r = 1; r < 16; ++r) pmax = fmaxf(pmax, p0[r]);
#pragma unroll
    for (int r = 0; r < 16; ++r) pmax = fmaxf(pmax, p1[r]);
    { auto rr = __builtin_amdgcn_permlane32_swap(__float_as_uint(pmax), __float_as_uint(pmax), false, false);
      pmax = fmaxf(__uint_as_float(rr[0]), __uint_as_float(rr[1])); }
    constexpr float C2 = 1.4426950408889634f * SCALE;
    if (__builtin_expect(__all((pmax - m_reg) * SCALE <= THR), 1)) { mn = m_reg; alpha = 1.f; }
    else { mn = fmaxf(m_reg, pmax); alpha = __builtin_amdgcn_exp2f((m_reg - mn) * C2); m_reg = mn; }
    const float mnL = -mn * C2;
#pragma unroll
    for (int r = 0; r < 16; ++r) p0[r] = fmaf(p0[r], C2, mnL);
#pragma unroll
    for (int r = 0; r < 16; ++r) p1[r] = fmaf(p1[r], C2, mnL);
#pragma unroll
    for (int r = 0; r < 16; ++r) p0[r] = __builtin_amdgcn_exp2f(p0[r]);
}
__device__ __forceinline__ void finishSM(f32x16& p0, f32x16& p1, float alpha, float& l_reg, bf16x8& pa0, bf16x8& pa1, bf16x8& pa2, bf16x8& pa3) {
#pragma unroll
    for (int r = 0; r < 16; ++r) p1[r] = __builtin_amdgcn_exp2f(p1[r]);
    float ps = 0;
#pragma unroll
    for (int r = 0; r < 16; ++r) ps += p0[r];
#pragma unroll
    for (int r = 0; r < 16; ++r) ps += p1[r];
    { auto rr = __builtin_amdgcn_permlane32_swap(__float_as_uint(ps), __float_as_uint(ps), false, false);
      ps = __uint_as_float(rr[0]) + __uint_as_float(rr[1]); }
    l_reg = l_reg * alpha + ps;
#define PK4(P, B_, OUT) do { unsigned a0 = cvtpk(P[B_+0], P[B_+1]), a1 = cvtpk(P[B_+2], P[B_+3]);                          \
        unsigned b0 = cvtpk(P[B_+4], P[B_+5]), b1 = cvtpk(P[B_+6], P[B_+7]);                                             \
        auto r0 = __builtin_amdgcn_permlane32_swap(a0, b0, false, false); auto r1 = __builtin_amdgcn_permlane32_swap(a1, b1, false, false); \
        u32x4 w = {r0[0], r1[0], r0[1], r1[1]}; OUT = *reinterpret_cast<bf16x8*>(&w); } while (0)
    PK4(p0, 0, pa0); PK4(p0, 8, pa1); PK4(p1, 0, pa2); PK4(p1, 8, pa3);
#undef PK4
}
template <int KB>
__device__ __forceinline__ void qkt(f32x16& p0, f32x16& p1, const char* K_lds, int r32, int hi, const bf16x8* qr) {
    p0 = f32x16{}; p1 = f32x16{};
    const char* kb[4];
#pragma unroll
    for (int dd = 0; dd < 4; ++dd) kb[dd] = K_lds + KB * SHM_K + KSWZ(r32, (dd * 16 + hi * 8) * 2);
#pragma unroll
    for (int d0 = 0; d0 < 8; ++d0) { const char* a = kb[d0 & 3] + (d0 >> 2) * 128;
        bf16x8 b0 = *reinterpret_cast<const bf16x8*>(a);
        bf16x8 b1 = *reinterpret_cast<const bf16x8*>(a + 32 * 256);
        p0 = __builtin_amdgcn_mfma_f32_32x32x16_bf16(b0, qr[d0], p0, 0, 0, 0);
        p1 = __builtin_amdgcn_mfma_f32_32x32x16_bf16(b1, qr[d0], p1, 0, 0, 0); }
}
template <int VB>
__device__ __forceinline__ void pv_tile(f32x16* o, int vb0, bf16x8 pa0, bf16x8 pa1, bf16x8 pa2, bf16x8 pa3) {
#define TRRD(dst, off) asm volatile("ds_read_b64_tr_b16 %0, %1 offset:%2" : "=&v"(dst) : "v"(vb0), "i"(off) : "memory")
#define PV_D0(d0) do { s16x4 l0, l1, l2, l3, h0, h1, h2, h3; constexpr int b_ = VB * SHM_V + v_rd_off(d0, 0, 0);     \
        TRRD(l0, b_); TRRD(h0, b_ + 2048); TRRD(l1, b_ + 4096); TRRD(h1, b_ + 6144); TRRD(l2, b_ + 8192); TRRD(h2, b_ + 10240); TRRD(l3, b_ + 12288); TRRD(h3, b_ + 14336); \
        asm volatile("s_waitcnt lgkmcnt(0)" ::: "memory"); SBAR();                                                                \
        o[d0] = __builtin_amdgcn_mfma_f32_32x32x16_bf16(pa0, (bf16x8){l0[0], l0[1], l0[2], l0[3], h0[0], h0[1], h0[2], h0[3]}, o[d0], 0, 0, 0);   \
        o[d0] = __builtin_amdgcn_mfma_f32_32x32x16_bf16(pa1, (bf16x8){l1[0], l1[1], l1[2], l1[3], h1[0], h1[1], h1[2], h1[3]}, o[d0], 0, 0, 0);   \
        o[d0] = __builtin_amdgcn_mfma_f32_32x32x16_bf16(pa2, (bf16x8){l2[0], l2[1], l2[2], l2[3], h2[0], h2[1], h2[2], h2[3]}, o[d0], 0, 0, 0);   \
        o[d0] = __builtin_amdgcn_mfma_f32_32x32x16_bf16(pa3, (bf16x8){l3[0], l3[1], l3[2], l3[3], h3[0], h3[1], h3[2], h3[3]}, o[d0], 0, 0, 0); } while (0)
    PV_D0(0); PV_D0(1); PV_D0(2); PV_D0(3);
#undef PV_D0
#undef TRRD
}
constexpr int LDZ = ZLD, LDO = 1024;
#define ROW(p, k0, rr) ((p) + (size_t)((k0) + (rr)) * LDZ + sc)
#define VMW() asm volatile("s_waitcnt vmcnt(0)" ::: "memory")
#define SLOAD_H(Kp, Vp, k0) do { st_v0 = ld8(ROW(Vp, k0, sr)); st_v1 = ld8(ROW(Vp, k0, 32 + sr));              \
                         st_k0 = ld8(ROW(Kp, k0, sr)); st_k1 = ld8(ROW(Kp, k0, 32 + sr)); } while (0)
#define SWRITE_H(bf) do { *(bf16x8*)(V_lds + (bf) * SHM_V + vst0) = st_v0; *(bf16x8*)(V_lds + (bf) * SHM_V + vst1) = st_v1;      \
                          *(bf16x8*)(K_lds + (bf) * SHM_K + kws) = st_k0; *(bf16x8*)(K_lds + (bf) * SHM_K + kws + 32 * 256) = st_k1; } while (0)
template <bool CAUSAL>
__device__ __forceinline__ void moba_core(const bf16_t* qrow, const bf16_t* Kh, const bf16_t* Vh, int kb0, char* lds, int tid, f32x16 (&o)[4], float& m_reg, float& l_reg) {
    const int wid = __builtin_amdgcn_readfirstlane(tid >> 6), lane = tid & 63, r32 = lane & 31, hi = lane >> 5;
    constexpr int NT = 4;
    const int qlo = wid * QBLK, qm = qlo + r32 - 4 * hi;
    char* V_lds = lds; char* K_lds = lds + 2 * SHM_V;
    float* ws = (float*)(lds + 2 * SHM_V + 2 * SHM_K) + wid * 64; float* al_l = ws + 32;
    m_reg = -1e30f; l_reg = 0;
#pragma unroll
    for (int d = 0; d < 4; ++d) o[d] = f32x16{};
    const int sr = tid >> 4, sc = (tid & 15) * 8, vst0 = v_st(sr, sc), vst1 = v_st(32 + sr, sc), kws = KSWZ(sr, sc * 2);
    const int vb0 = (int)(uintptr_t)V_lds + v_rd_base(lane);
    bf16x8 qr[8], st_v0, st_v1, st_k0, st_k1;
#pragma unroll
    for (int d0 = 0; d0 < 8; ++d0) qr[d0] = ld8(qrow + d0 * 16 + hi * 8);
    SLOAD_H(Kh, Vh, kb0); VMW(); SWRITE_H(0);
    __syncthreads();
#define RESC(a) do { if (__any((a) < 1.f)) { if (hi == 0) al_l[r32] = (a); asm volatile("s_waitcnt lgkmcnt(0)" ::: "memory");              \
                     for (int d_ = 0; d_ < 4; ++d_) for (int r = 0; r < 16; ++r) o[d_][r] *= al_l[crow(r, hi)]; } } while (0)
#define TILE_STEP(t, BUF) do { f32x16 p0, p1; float mn, al; bf16x8 pa0, pa1, pa2, pa3;                                         \
        if ((t) + 1 < NT) { SLOAD_H(Kh, Vh, kb0 + ((t) + 1) * KVBLK); } SBAR();                                                   \
        qkt<BUF>(p0, p1, K_lds, r32, hi, qr);                                                                                   \
        if (CAUSAL) { if ((t) * KVBLK + KVBLK - 1 > qlo) mask_causal(p0, p1, qm - (t) * KVBLK); }                               \
        partialSM(p0, p1, m_reg, mn, al); RESC(al); finishSM(p0, p1, al, l_reg, pa0, pa1, pa2, pa3); SBAR();                    \
        pv_tile<BUF>(o, vb0, pa0, pa1, pa2, pa3); SBAR();                                                                      \
        if ((t) + 1 < NT) { VMW(); SWRITE_H(1 - BUF); }                                                                        \
        __syncthreads(); } while (0)
    TILE_STEP(0, 0); TILE_STEP(1, 1); TILE_STEP(2, 0); TILE_STEP(3, 1);
#undef RESC
#undef TILE_STEP
}
__device__ __forceinline__ void moba_past_tile(const bf16_t* Zb  , int h, int j, const unsigned* list, int cnt, int e0, bf16_t* PARTbh, float* MLbh, char* lds) {
    int tid = threadIdx.x; asm volatile("" : "+v"(tid));
    const int wid = __builtin_amdgcn_readfirstlane(tid >> 6), lane = tid & 63, r32 = lane & 31;
    const int e = e0 + wid * QBLK + r32; const bool valid = e < cnt;
    const unsigned ent = list[valid ? e : 0];
    const bf16_t* qrow = Zb + (size_t)(ent & 0xffffu) * LDZ + ZC_Q + h * 128;
    f32x16 o[4]; float m_reg, l_reg;
    moba_core<false>(qrow, Zb + ZC_KB + h * 128, Zb + ZC_VB + h * 128, j * 256, lds, tid, o, m_reg, l_reg);
    int lane_e = lane; asm volatile("" : "+v"(lane_e));
    const int r32e = lane_e & 31, hie = lane_e >> 5;
    float* ws = (float*)(lds + 2 * SHM_V + 2 * SHM_K) + wid * 64; float* li_l = ws; unsigned* en_l = (unsigned*)(ws + 32);
    if (hie == 0) { li_l[r32e] = l_reg; en_l[r32e] = valid ? ent : 0xffffffffu;
        if (valid) *(f32x2*)(MLbh + ((size_t)(ent & 0xffffu) * 3 + (ent >> 16)) * 2) = (f32x2){m_reg, l_reg}; }
    asm volatile("s_waitcnt lgkmcnt(0)" ::: "memory");
#pragma unroll
    for (int r = 0; r < 16; ++r) { const int orow = crow(r, hie); const float rl = __builtin_amdgcn_rcpf(li_l[orow]); const unsigned en = en_l[orow];
        bf16_t* dst = PARTbh + ((size_t)(en & 0xffffu) * 3 + (en >> 16)) * 128;
#pragma unroll
        for (int d0 = 0; d0 < 4; ++d0) { const float v = o[d0][r] * rl; const float vn = __shfl_xor(v, 1);
            if ((r32e & 1) == 0 && en != 0xffffffffu) *(unsigned*)(dst + d0 * 32 + r32e) = cvtpk(v, vn); } }
    asm volatile("s_waitcnt lgkmcnt(0)" ::: "memory");
    __syncthreads();
}
__device__ __forceinline__ void moba_own_unit(const bf16_t* Zb, int h, int qb, int nsel, const bf16_t* PARTbh, const float* MLbh, bf16_t* Ob  , char* lds) {
    int tid = threadIdx.x; asm volatile("" : "+v"(tid));
    const int wid = __builtin_amdgcn_readfirstlane(tid >> 6), lane = tid & 63, r32 = lane & 31;
    const int t = qb * 256 + wid * QBLK + r32;
    f32x16 o[4]; float m_reg, l_reg;
    moba_core<true>(Zb + (size_t)t * LDZ + ZC_Q + h * 128, Zb + ZC_KB + h * 128, Zb + ZC_VB + h * 128, qb * 256, lds, tid, o, m_reg, l_reg);
    int lane_e = lane; asm volatile("" : "+v"(lane_e));
    const int r32e = lane_e & 31, hie = lane_e >> 5, te = qb * 256 + wid * QBLK + r32e;
    float* ws = (float*)(lds + 2 * SHM_V + 2 * SHM_K) + wid * 64; float* f_l = ws;
    float* fl = (float*)(lds + 2 * SHM_V + 2 * SHM_K + NW * 64 * 4) + wid * 128;
    constexpr float C2 = 1.4426950408889634f * SCALE;
    float ms[3], ls[3]; float M = m_reg;
#pragma unroll
    for (int s = 0; s < 3; ++s) { ms[s] = -1e30f; ls[s] = 0.f; if (s < nsel) { const f32x2 ml = *(const f32x2*)(MLbh + ((size_t)te * 3 + s) * 2); ms[s] = ml.x; ls[s] = ml.y; M = fmaxf(M, ml.x); } }
    const float wo = l_reg * __builtin_amdgcn_exp2f((m_reg - M) * C2);
    float w[3], W = wo;
#pragma unroll
    for (int s = 0; s < 3; ++s) { w[s] = ls[s] * __builtin_amdgcn_exp2f((ms[s] - M) * C2); W += w[s]; }
    const float rW = __builtin_amdgcn_rcpf(W);
    if (hie == 0) { fl[r32e] = __builtin_amdgcn_exp2f((m_reg - M) * C2) * rW;
#pragma unroll
        for (int s = 0; s < 3; ++s) fl[(s + 1) * 32 + r32e] = w[s] * rW; }
    asm volatile("s_waitcnt lgkmcnt(0)" ::: "memory");
    (void)f_l;
#pragma unroll
    for (int r = 0; r < 16; ++r) { const float f = fl[crow(r, hie)];
#pragma unroll
        for (int d0 = 0; d0 < 4; ++d0) o[d0][r] *= f; }
    bf16_t* gl = (bf16_t*)(lds + wid * 8192);
    for (int s = 0; s < nsel; ++s) {
        { const bf16_t* src = PARTbh + ((size_t)(qb * 256 + wid * QBLK) * 3 + s) * 128; const int lane2 = lane_e;
#pragma unroll
          for (int i = 0; i < 8; ++i) { const int rr = i * 4 + (lane2 >> 4), ch = lane2 & 15; *(bf16x8*)(gl + rr * 128 + ch * 8) = ld8(src + (size_t)rr * 384 + ch * 8); } }
        asm volatile("s_waitcnt vmcnt(0) lgkmcnt(0)" ::: "memory");
#pragma unroll
        for (int r = 0; r < 16; ++r) { const int orow = crow(r, hie); const float f = fl[(s + 1) * 32 + orow];
#pragma unroll
            for (int d0 = 0; d0 < 4; ++d0) o[d0][r] += f * bf2f(gl[orow * 128 + d0 * 32 + r32e]); }
        asm volatile("s_waitcnt lgkmcnt(0)" ::: "memory");
    }
    { const bf16_t* Gw = Zb + (size_t)(qb * 256 + wid * QBLK) * LDZ + ZC_GB + h * 128; const int lane2 = lane_e;
#pragma unroll
      for (int i = 0; i < 8; ++i) { const int rr = i * 4 + (lane2 >> 4), ch = lane2 & 15; *(bf16x8*)(gl + rr * 128 + ch * 8) = ld8(Gw + (size_t)rr * LDZ + ch * 8); } }
    asm volatile("s_waitcnt vmcnt(0) lgkmcnt(0)" ::: "memory");
    bf16_t* Ow = Ob + (size_t)(qb * 256 + wid * QBLK) * LDO;
#pragma unroll
    for (int r = 0; r < 16; ++r) { const int orow = crow(r, hie);
#pragma unroll
        for (int d0 = 0; d0 < 4; ++d0) { const float v = o[d0][r] * bf2f(gl[orow * 128 + d0 * 32 + r32e]); const float vn = __shfl_xor(v, 1);
            if ((r32e & 1) == 0) *(unsigned*)(Ow + (size_t)orow * LDO + d0 * 32 + r32e) = cvtpk(v, vn); } }
    asm volatile("s_waitcnt lgkmcnt(0)" ::: "memory");
    __syncthreads();
}
#undef ROW
#undef VMW
#undef SLOAD_H
#undef SWRITE_H
}
constexpr size_t MiB = 1u << 20;
constexpr size_t WS_CTL = 0, CTL_ZERO_BYTES = 1 * MiB;
constexpr size_t WS_WINT = 2 * MiB;
constexpr size_t WS_PAT = 52 * MiB, WS_PBT = 56 * MiB, WS_WOT = 60 * MiB;
constexpr size_t WS_XN = 68 * MiB;
constexpr size_t WS_XS = 100 * MiB;
constexpr size_t WS_ROPE = 101 * MiB;
constexpr size_t WS_ZS = 102 * MiB;
constexpr size_t WS_KMP = 103 * MiB;
constexpr size_t WS_Z = 104 * MiB;
constexpr size_t WS_OA = 300 * MiB, WS_OB = 317 * MiB;
constexpr size_t WS_MRG = 334 * MiB;
constexpr size_t WS_TMP = 367 * MiB;
constexpr size_t WS_KMS = 644 * MiB;
constexpr size_t WS_CPM = 448 * MiB, WS_CQ = 464 * MiB, WS_CYQ = 496 * MiB, WS_CYL = 512 * MiB, WS_CBV = 544 * MiB, WS_CSG = 560 * MiB, WS_CSC = 576 * MiB;
constexpr size_t WS_LST = 436 * MiB;
constexpr size_t WS_PART = 592 * MiB, WS_ML = 640 * MiB;
constexpr size_t WS_END = 660 * MiB;
constexpr int CW_BAR = 4096;
constexpr int CW_CNT = 12288;
constexpr int CW_QKM = 8192;

constexpr int RING_BYTES = 131072, LDS_BYTES = 147456, LDSCTL_OFF = LDS_BYTES - 1024, MISC_OFF = LDSCTL_OFF + 320;
constexpr int NWAVES = 8, NTHR = 512;

#define XB_TMO      128
#define XB_XCNT(j)  (256  + 64 * (j))
#define XB_XSUB(j)  (1280 + 64 * (j))
#define XB_XGEN(j)  (2304 + 64 * (j))
#define XB_TOP      3328
#define XB_TOPGEN   3392
#define XCD_BAR_WORDS 3456
#define XB_SPIN_CAP (1u << 18)
__device__ __forceinline__ unsigned xb_ld(unsigned* p)              { return __hip_atomic_load(p, __ATOMIC_RELAXED, __HIP_MEMORY_SCOPE_AGENT); }
__device__ __forceinline__ unsigned xb_add(unsigned* p, unsigned v) { return __hip_atomic_fetch_add(p, v, __ATOMIC_RELAXED, __HIP_MEMORY_SCOPE_AGENT); }
__device__ __forceinline__ unsigned xb_xcc_id() { return (unsigned)__builtin_amdgcn_s_getreg((3 << 11) | 20) & 0xFu; }
#define XB_SPIN(cond, bar) do { unsigned _sp = 0; while (cond) { __builtin_amdgcn_s_sleep(1); \
    if ((++_sp & 255u) == 0u) { if (xb_ld(&(bar)[XB_TMO])) break; if (_sp > XB_SPIN_CAP) { atomicAdd(&(bar)[XB_TMO], 1u); break; } } } } while (0)
struct XcdBarrier { unsigned* bar; unsigned x; volatile LAS unsigned* st; };
__device__ __forceinline__ XcdBarrier xcd_barrier_post(unsigned* bar, volatile LAS unsigned* st) {
    XcdBarrier b; b.bar = bar; b.x = xb_xcc_id(); b.st = st;
    if (threadIdx.x == 0) (void)xb_add(&bar[XB_XCNT(b.x)], 1u);
    return b;
}
__device__ __forceinline__ void xcd_barrier_complete(unsigned* bar, unsigned x, unsigned& nloc, unsigned& nx) {
    const unsigned G = gridDim.x * gridDim.y * gridDim.z;
    unsigned sum, cnt, mine, sp = 0u;
    for (;;) {
        sum = 0u; cnt = 0u; mine = 0u;
#pragma unroll
        for (unsigned j = 0; j < 16; ++j) { const unsigned c = xb_ld(&bar[XB_XCNT(j)]); sum += c; cnt += (c > 0u) ? 1u : 0u; mine = (j == x) ? c : mine; }
        if (sum == G) break;
        __builtin_amdgcn_s_sleep(1);
        if ((++sp & 255u) == 0u) { if (xb_ld(&bar[XB_TMO])) break; if (sp > XB_SPIN_CAP) { atomicAdd(&bar[XB_TMO], 1u); break; } }
    }
    nloc = mine > 0u ? mine : 1u; nx = cnt > 0u ? cnt : 1u;
}
__device__ __forceinline__ void xcd_barrier(const XcdBarrier& b) {
    asm volatile("s_waitcnt vmcnt(0)" ::: "memory");
    __syncthreads();
    if (threadIdx.x == 0) {
        unsigned* bar = b.bar;
        __builtin_amdgcn_s_waitcnt(0);
        unsigned nloc = b.st[0], nx = b.st[1];
        if (nloc == 0u) { xcd_barrier_complete(bar, b.x, nloc, nx); b.st[0] = nloc; b.st[1] = nx; }
        const unsigned old = xb_add(&bar[XB_XSUB(b.x)], 1u);
        const unsigned gen = old / nloc;
        if (old + 1u == (gen + 1u) * nloc) {
            __builtin_amdgcn_fence(__ATOMIC_RELEASE, "agent");
            asm volatile("s_waitcnt vmcnt(0)" ::: "memory");
            const unsigned og = xb_add(&bar[XB_TOP], 1u);
            const unsigned tg = og / nx;
            if (og + 1u == (tg + 1u) * nx) xb_add(&bar[XB_TOPGEN], 1u);
            else XB_SPIN(xb_ld(&bar[XB_TOPGEN]) == tg, bar);
            __builtin_amdgcn_fence(__ATOMIC_ACQUIRE, "agent");
            xb_add(&bar[XB_XGEN(b.x)], 1u);
            asm volatile("s_waitcnt vmcnt(0)" ::: "memory");
        } else {
            XB_SPIN(xb_ld(&bar[XB_XGEN(b.x)]) == gen, bar);
            __builtin_amdgcn_fence(__ATOMIC_ACQUIRE, "agent");
            asm volatile("s_waitcnt vmcnt(0)" ::: "memory");
        }
    }
    __syncthreads();
}

struct Args { const void* in[23]; float* out; unsigned char* ws; int ph_lo, ph_hi; };
struct Frame {
    LAS unsigned char* lds; char* ldsg;
    int tid, lane, wave, G, bid;
    const float *x_p, *x_s, *st_shift, *st_wkv, *cache_k, *cache_v; const int* page_table;
    const float *ln_w, *w_in, *mu, *w0, *w2, *a0, *a2, *k_k, *k_a, *r_k, *lnx_w, *lnx_b, *p_a, *p_b, *w_o, *final_w;
    float* out; unsigned char* ws;
};

__device__ __forceinline__ void p0_transpose_item(const float* W, int K, int N, bf16_t* WT, int dst_n0, int src_n0, int k0, LAS float* scr, int lane, bool perm) {
    if (src_n0 >= 0) {
#pragma unroll 8
        for (int i = 0; i < 32; ++i) { const int kk = 2 * i + (lane >> 5); scr[kk * 33 + (lane & 31)] = W[(size_t)(k0 + kk) * N + src_n0 + (lane & 31)]; }
    } else {
#pragma unroll 8
        for (int i = 0; i < 32; ++i) { const int kk = 2 * i + (lane >> 5); scr[kk * 33 + (lane & 31)] = 0.f; }
    }
    LDS_WAIT(); asm volatile("" ::: "memory");
    const int c = lane & 7;
#pragma unroll
    for (int j = 0; j < 4; ++j) { const int n = (lane >> 3) + 8 * j; const LAS float* s = scr + (8 * c) * 33 + n;
        u32x4 o; o.x = cvt_pk_bf16(s[0 * 33], s[1 * 33]); o.y = cvt_pk_bf16(s[2 * 33], s[3 * 33]); o.z = cvt_pk_bf16(s[4 * 33], s[5 * 33]); o.w = cvt_pk_bf16(s[6 * 33], s[7 * 33]);
        *(u32x4*)(WT + (size_t)(perm ? wrow(dst_n0 + n) : dst_n0 + n) * K + k0 + 8 * c) = o; }
    LDS_WAIT(); asm volatile("" ::: "memory");
}
__device__ __forceinline__ void rms_row(const float* xrow, const float* w, bf16_t* orow, float* frow, int lane) {
    const f32x4* xr = (const f32x4*)xrow + lane; const f32x4* wr = (const f32x4*)w + lane;
    f32x4 v[8]; float s = 0.f;
#pragma unroll
    for (int j = 0; j < 8; ++j) { v[j] = xr[64 * j]; s += (v[j].x * v[j].x + v[j].y * v[j].y) + (v[j].z * v[j].z + v[j].w * v[j].w); }
    const float rstd = 1.0f / sqrtf(wave_sum(s) * (1.f / DM) + NORM_EPS);
#pragma unroll
    for (int j = 0; j < 8; ++j) { const f32x4 y = v[j] * rstd * wr[64 * j];
        u32x2 o; o.x = cvt_pk_bf16(y.x, y.y); o.y = cvt_pk_bf16(y.z, y.w);
        *((u32x2*)orow + lane + 64 * j) = o;
        if (frow) *((f32x4*)frow + lane + 64 * j) = y; }
}
__device__ __forceinline__ void phase_prologue(Frame& F) {
    LAS float* scr = (LAS float*)(F.lds + F.wave * 16384);
    const int gw = F.bid * NWAVES + F.wave, NGW = F.G * NWAVES;
    bf16_t* WinT = (bf16_t*)(F.ws + WS_WINT); bf16_t* PaT = (bf16_t*)(F.ws + WS_PAT); bf16_t* PbT = (bf16_t*)(F.ws + WS_PBT); bf16_t* WoT = (bf16_t*)(F.ws + WS_WOT);
    constexpr int I_IN = 32 * (ZLD / 32), I_P = 16 * 64, I_O = 32 * 64, NITEMS = I_IN + 2 * I_P + I_O;
    for (int it = gw; it < NITEMS; it += NGW) {
        int r = it;
        if (r < I_IN) { const int dg = r % (ZLD / 32), kb = r / (ZLD / 32); p0_transpose_item(F.w_in, DM, NIN, WinT, dg * 32, zcol_to_src(dg * 32), kb * 64, scr, F.lane, dg * 32 < ZC_WLO); continue; } r -= I_IN;
        if (r < I_P) { const int dg = r % 64, kb = r / 64; p0_transpose_item(F.p_a, DA, DM, PaT, dg * 32, dg * 32, kb * 64, scr, F.lane, true); continue; } r -= I_P;
        if (r < I_P) { const int dg = r % 64, kb = r / 64; p0_transpose_item(F.p_b, DBB, DM, PbT, dg * 32, dg * 32, kb * 64, scr, F.lane, true); continue; } r -= I_P;
        { const int dg = r % 64, kb = r / 64; p0_transpose_item(F.w_o, DM, DM, WoT, dg * 32, dg * 32, kb * 64, scr, F.lane, true); }
    }
    bf16_t* XN = (bf16_t*)(F.ws + WS_XN); bf16_t* XS = (bf16_t*)(F.ws + WS_XS);
    for (int m = gw; m < MP + 16; m += NGW) {
        if (m < MP) { const bool last = (m & (TSEQ - 1)) == TSEQ - 1; rms_row(F.x_p + (size_t)m * DM, F.ln_w, XN + (size_t)m * DM, last ? F.out + O_SHP + (size_t)(m / TSEQ) * DM : nullptr, F.lane); }
        else if (m < MP + 8) { const int b = m - MP; rms_row(F.x_s + (size_t)b * DM, F.ln_w, XS + (size_t)b * DM, F.out + O_SHS + (size_t)b * DM, F.lane); }
        else { const int b = m - MP - 8; const f32x4* sr = (const f32x4*)(F.st_shift + (size_t)b * DM) + F.lane;
#pragma unroll
            for (int j = 0; j < 8; ++j) { const f32x4 y = sr[64 * j]; u32x2 o; o.x = cvt_pk_bf16(y.x, y.y); o.y = cvt_pk_bf16(y.z, y.w); *((u32x2*)(XS + (size_t)(8 + b) * DM) + F.lane + 64 * j) = o; } }
    }
    float* rope = (float*)(F.ws + WS_ROPE);
    for (int i = F.bid * NTHR + F.tid; i < 4097 * 16; i += F.G * NTHR) {
        const int p = i >> 4, k = i & 15; const double pos = (p < 4096) ? (double)p : (double)PAST;
        const float inv = powf(500000.0f, -(float)k * (2.0f / 32.0f));
        const float ang = (float)pos * inv;
        rope[p * 32 + k] = (float)cos((double)ang); rope[p * 32 + 16 + k] = (float)sin((double)ang);
    }
    { bf16_t* OA = (bf16_t*)(F.ws + WS_OA) + (size_t)(MP + 8) * 1024; bf16_t* OB = (bf16_t*)(F.ws + WS_OB) + (size_t)(MP + 8) * 1024; bf16_t* MG = (bf16_t*)(F.ws + WS_MRG) + (size_t)(MP + 8) * DM;
      for (int i = F.bid * NTHR + F.tid; i < 8 * 1024; i += F.G * NTHR) { OA[i] = 0; OB[i] = 0; MG[i] = 0; MG[i + 8 * 1024] = 0; } }
}

template <int K>
__device__ __forceinline__ f32x4 skinny_tile(const LAS bf16_t* As, int lda, const bf16_t* WT, int n0, int lane) {
    const int r = lane & 15, q = lane >> 4;
    const bf16_t* bp = WT + (size_t)wrow_in(n0 + r) * K + q * 8;
    const LAS bf16_t* ap = As + r * lda + q * 8;
    f32x4 acc = {0.f, 0.f, 0.f, 0.f};
#pragma unroll 8
    for (int k = 0; k < K; k += 32) {
        const bf16x8 a = *(const LAS bf16x8*)(ap + k);
        const bf16x8 b = *(const bf16x8*)(bp + k);
        acc = __builtin_amdgcn_mfma_f32_16x16x32_bf16(a, b, acc, 0, 0, 0);
    }
    return acc;
}
template <int K>
__device__ __forceinline__ void stage_rows16(const bf16_t* src, LAS bf16_t* dst, int tid) {
    for (int i = tid; i < 16 * K / 8; i += NTHR) { const int r = i / (K / 8), c = i % (K / 8); *(LAS u32x4*)(dst + r * (K + 8) + c * 8) = *(const u32x4*)(src + (size_t)r * K + c * 8); }
}
__device__ __forceinline__ void phase_inproj_sample(Frame& F) {
    LAS bf16_t* As = (LAS bf16_t*)F.lds;
    stage_rows16<DM>((const bf16_t*)(F.ws + WS_XS), As, F.tid);
    LDS_WAIT(); __syncthreads();
    const bf16_t* WinT = (const bf16_t*)(F.ws + WS_WINT); float* ZS = (float*)(F.ws + WS_ZS);
    const int gw = F.bid * NWAVES + F.wave, NGW = F.G * NWAVES;
    for (int tile = gw; tile < ZLD / 16; tile += NGW) {
        const f32x4 acc = skinny_tile<DM>(As, DM + 8, WinT, tile * 16, F.lane);
        const int q = F.lane >> 4, n = tile * 16 + (F.lane & 15);
#pragma unroll
        for (int r = 0; r < 4; ++r) ZS[(size_t)(4 * q + r) * ZLD + n] = acc[r];
    }
    __syncthreads();
}

__device__ __forceinline__ void lora_unit(Frame& F, int unit) {
    LAS bf16_t* As = (LAS bf16_t*)F.lds;
    const bf16_t* src = (const bf16_t*)(F.ws + WS_XN) + (size_t)unit * 32 * DM;
    for (int i = F.tid; i < 32 * DM / 8; i += NTHR) { const int r = i >> 8, c = i & 255; *(LAS u32x4*)(As + r * (DM + 8) + c * 8) = *(const u32x4*)(src + (size_t)r * DM + c * 8); }
    LDS_WAIT(); __syncthreads();
    const int r = F.lane & 15, q = F.lane >> 4, n0 = F.wave * 16;
    const bf16_t* bp = (const bf16_t*)(F.ws + WS_WINT) + (size_t)(ZC_WLO + n0 + r) * DM + q * 8;
    const LAS bf16_t* ap = As + r * (DM + 8) + q * 8;
    f32x4 acc0 = {0.f, 0.f, 0.f, 0.f}, acc1 = acc0;
#pragma unroll 8
    for (int k = 0; k < DM; k += 32) {
        const bf16x8 bfr = *(const bf16x8*)(bp + k);
        const bf16x8 a0 = *(const LAS bf16x8*)(ap + k), a1 = *(const LAS bf16x8*)(ap + 16 * (DM + 8) + k);
        acc0 = __builtin_amdgcn_mfma_f32_16x16x32_bf16(bfr, a0, acc0, 0, 0, 0);
        acc1 = __builtin_amdgcn_mfma_f32_16x16x32_bf16(bfr, a1, acc1, 0, 0, 0);
    }
    bf16_t* Z = (bf16_t*)(F.ws + WS_Z) + ((size_t)unit * 32 + r) * ZLD + ZC_WLO + n0 + 4 * q;
    mfma_fence4(acc0); mfma_fence4(acc1);
    u32x2 w0, w1; w0.x = cvt_pk_bf16(acc0[0], acc0[1]); w0.y = cvt_pk_bf16(acc0[2], acc0[3]); w1.x = cvt_pk_bf16(acc1[0], acc1[1]); w1.y = cvt_pk_bf16(acc1[2], acc1[3]);
    *(u32x2*)Z = w0; *(u32x2*)(Z + (size_t)16 * ZLD) = w1;
    __syncthreads();
}
__device__ __forceinline__ void moba_select_unit(Frame& F, int unit) {
    const int qb = 1 + (unit >> 4), bh = unit & 15, b = bh >> 3, h = bh & 7;
    const bf16_t* Z = (const bf16_t*)(F.ws + WS_Z); const float* kmp = (const float*)(F.ws + WS_KMP);
    LAS float* km = (LAS float*)(F.lds + att::ATT_LDS);
    LAS unsigned* sel = (LAS unsigned*)(F.lds + att::ATT_LDS + 16 * 132 * 4);
    for (int idx = F.tid; idx < qb * 128; idx += NTHR) { const int n = idx >> 7, d = idx & 127; const int pm = b * 16 + n, col = h * 128 + d;
        km[n * 132 + d] = (kmp[(size_t)(pm * 2 + 0) * 1024 + col] + kmp[(size_t)(pm * 2 + 1) * 1024 + col]) * (1.0f / 256.0f); }
    LDS_WAIT(); __syncthreads();
    {
        int tid_g = F.tid; asm volatile("" : "+v"(tid_g));
        const int row = tid_g >> 1, part = tid_g & 1;
        const bf16_t* qp = Z + (size_t)(b * TSEQ + qb * 256 + row) * ZLD + ZC_Q + h * 128 + part * 64;
        float q[64];
#pragma unroll
        for (int c8 = 0; c8 < 8; ++c8) { float t8[8]; ld8bf(qp + c8 * 8, t8);
#pragma unroll
            for (int e = 0; e < 8; ++e) q[c8 * 8 + e] = t8[e]; }
        float g[15];
#pragma unroll
        for (int n = 0; n < 15; ++n) { float s = 0.f;
            if (n < qb) {
#pragma unroll
                for (int d4 = 0; d4 < 16; ++d4) { const f32x4 kv = *(const LAS f32x4*)(km + n * 132 + part * 64 + d4 * 4);
                    s += (q[d4 * 4] * kv.x + q[d4 * 4 + 1] * kv.y) + (q[d4 * 4 + 2] * kv.z + q[d4 * 4 + 3] * kv.w); }
            }
            s += __shfl_xor(s, 1); g[n] = s; }
        unsigned mask = 0u;
#pragma unroll
        for (int pass = 0; pass < 3; ++pass) { float best = -__builtin_inff(); int bi = -1;
#pragma unroll
            for (int n = 0; n < 15; ++n) { const bool ok = (n < qb) && !((mask >> n) & 1u) && (g[n] > best); best = ok ? g[n] : best; bi = ok ? n : bi; }
            if (bi >= 0) mask |= 1u << bi; }
        if (part == 0) sel[row] = mask;
    }
    LDS_WAIT(); __syncthreads();
    unsigned* CNT = (unsigned*)(F.ws + WS_CTL) + CW_CNT; unsigned* LST = (unsigned*)(F.ws + WS_LST);
    for (int j = F.wave; j < qb; j += NWAVES) {
        unsigned mk[4]; int c = 0;
#pragma unroll
        for (int k = 0; k < 4; ++k) { mk[k] = sel[4 * F.lane + k]; c += (int)((mk[k] >> j) & 1u); }
        int incl = c;
#pragma unroll
        for (int off = 1; off < 64; off <<= 1) { const int up = __shfl_up(incl, off); incl += (F.lane >= off) ? up : 0; }
        const int total = __shfl(incl, 63);
        unsigned base = 0u; if (F.lane == 0) base = __hip_atomic_fetch_add(CNT + bh * 15 + j, (unsigned)total, __ATOMIC_RELAXED, __HIP_MEMORY_SCOPE_AGENT);
        base = (unsigned)__shfl((int)base, 0);
        unsigned off = base + (unsigned)(incl - c); unsigned* lst = LST + (size_t)(bh * 15 + j) * 4096;
#pragma unroll
        for (int k = 0; k < 4; ++k) if ((mk[k] >> j) & 1u) { lst[off++] = (unsigned)(qb * 256 + 4 * F.lane + k) | ((unsigned)__popc(mk[k] & ((1u << j) - 1u)) << 16); }
    }
    __syncthreads();
}
__device__ __forceinline__ void moba_past_phase(Frame& F) {
    LAS int* toff = (LAS int*)(F.lds + 100000);
    const unsigned* CNT = (const unsigned*)(F.ws + WS_CTL) + CW_CNT;
    if (F.tid < 240) toff[F.tid + 1] = (int)((CNT[F.tid] + 255u) >> 8);
    LDS_WAIT(); __syncthreads();
    if (F.tid == 0) { int acc = 0; toff[0] = 0; for (int i = 1; i <= 240; ++i) { acc += toff[i]; toff[i] = acc; } }
    LDS_WAIT(); __syncthreads();
    const int T = toff[240];
    for (int g = F.bid; g < T; g += F.G) {
        int lo = 0, hi = 239;
        while (lo < hi) { const int mid = (lo + hi + 1) >> 1; if (toff[mid] <= g) lo = mid; else hi = mid - 1; }
        const int i = lo, bh = i / 15, j = i - bh * 15, tile = g - toff[i], b = bh >> 3, h = bh & 7;
        att::moba_past_tile((const bf16_t*)(F.ws + WS_Z) + (size_t)b * TSEQ * ZLD, h, j, (const unsigned*)(F.ws + WS_LST) + (size_t)i * 4096, (int)CNT[i], tile * 256,
                            (bf16_t*)(F.ws + WS_PART) + (size_t)bh * TSEQ * 384, (float*)(F.ws + WS_ML) + (size_t)bh * TSEQ * 6, F.ldsg);
    }
}
__device__ __forceinline__ void moba_own(Frame& F, int unit) {
    const int qb = unit >> 4, bh = unit & 15, b = bh >> 3, h = bh & 7;
    att::moba_own_unit((const bf16_t*)(F.ws + WS_Z) + (size_t)b * TSEQ * ZLD, h, qb, qb < 3 ? qb : 3, (const bf16_t*)(F.ws + WS_PART) + (size_t)bh * TSEQ * 384, (const float*)(F.ws + WS_ML) + (size_t)bh * TSEQ * 6,
                       (bf16_t*)(F.ws + WS_OB) + (size_t)b * TSEQ * 1024 + h * 128, F.ldsg);
}

__device__ __forceinline__ void sample_kmean_page(Frame& F, int unit) {
    const int b = unit >> 7, pg = unit & 127, cq = F.tid & 255, rg = F.tid >> 8;
    const int page = F.page_table[b * NPG + pg];
    const f32x4* src = (const f32x4*)(F.cache_k + (size_t)page * PAGE * 1024) + cq;
    f32x4 acc = {0.f, 0.f, 0.f, 0.f};
#pragma unroll 16
    for (int r = rg; r < PAGE; r += 2) acc += __builtin_nontemporal_load(src + (size_t)r * 256);
    LAS f32x4* red = (LAS f32x4*)F.lds;
    if (rg == 1) red[cq] = acc;
    LDS_WAIT(); __syncthreads();
    if (rg == 0) { acc += red[cq]; *((f32x4*)((float*)(F.ws + WS_KMS) + (size_t)unit * 1024) + cq) = acc; }
    __syncthreads();
}
__device__ __forceinline__ int queue_pop(Frame& F, unsigned* ctr) {
    volatile LAS int* tk = (volatile LAS int*)(F.lds + LDSCTL_OFF + 64);
    __syncthreads();
    if (F.tid == 0) *tk = (int)__hip_atomic_fetch_add(ctr, 1u, __ATOMIC_RELAXED, __HIP_MEMORY_SCOPE_AGENT);
    __syncthreads();
    return *tk;
}
__device__ __forceinline__ void sample_attn_unit(Frame& F, int unit) {
    const int b = unit >> 3, h = unit & 7;
    const float* ZS = (const float*)(F.ws + WS_ZS) + (size_t)b * ZLD; const float* rope = (const float*)(F.ws + WS_ROPE) + 4096 * 32;
    LAS float* q = (LAS float*)F.lds; LAS float* kn = q + 128; LAS float* sc = kn + 128; LAS float* redm = sc + 800; LAS int* selb = (LAS int*)(redm + 16); LAS float* oacc = redm + 32;
    if (F.tid < 256) {
        const int d = F.tid & 127, isk = F.tid >> 7; const float* src = ZS + (isk ? ZC_KB : ZC_Q) + h * 128;
        float v = src[d];
        if (d < 32) { const int i = d & 15; const float c = rope[i], s = rope[16 + i]; const float x1 = src[i], x2 = src[16 + i]; v = (d < 16) ? (x1 * c - x2 * s) : (x2 * c + x1 * s); }
        (isk ? kn : q)[d] = v;
        if (isk) { F.out[O_KS + (size_t)b * 1024 + h * 128 + d] = v; F.out[O_VS + (size_t)b * 1024 + h * 128 + d] = ZS[ZC_VB + h * 128 + d]; }
    }
    LDS_WAIT(); __syncthreads();
    if (F.wave == 0) {
        const float* km = (const float*)(F.ws + WS_KMS) + ((size_t)b * 128 + 2 * F.lane) * 4 * 1024 + h * 128; float g = 0.f;
        for (int d = 0; d < 128; d += 4) { f32x4 kv = *(const f32x4*)(km + d);
#pragma unroll
            for (int p = 1; p < 8; ++p) kv += *(const f32x4*)(km + (size_t)p * 1024 + d);
            kv = kv * (1.0f / 256.0f); g += (q[d] * kv.x + q[d + 1] * kv.y) + (q[d + 2] * kv.z + q[d + 3] * kv.w); }
        for (int pass = 0; pass < 3; ++pass) { const float mx = wave_max(g); const unsigned long long bal = __ballot(g == mx); const int bi = __ffsll((long long)bal) - 1;
            if (F.lane == 0) selb[pass] = bi; if (F.lane == bi) g = -__builtin_inff(); }
    }
    LDS_WAIT(); __syncthreads();
    LAS int* pgs = selb + 4;
    if (F.tid < 6) pgs[F.tid] = F.page_table[b * NPG + 2 * selb[F.tid >> 1] + (F.tid & 1)];
    LDS_WAIT(); __syncthreads();
    float smax = -__builtin_inff();
    { const int sub = F.lane & 7, kq = F.lane >> 3; float qv[16];
#pragma unroll
      for (int e = 0; e < 16; ++e) qv[e] = q[sub * 16 + e];
      for (int p0 = 0; p0 < 12; p0 += 4) {
          f32x4 kv[4][4];
#pragma unroll
          for (int pp = 0; pp < 4; ++pp) { const int kidx = ((p0 + pp) * 8 + F.wave) * 8 + kq; const float* kr = F.cache_k + ((size_t)pgs[kidx >> 7] * PAGE + (kidx & 127)) * 1024 + h * 128 + sub * 16;
#pragma unroll
              for (int e = 0; e < 4; ++e) kv[pp][e] = *(const f32x4*)(kr + 4 * e); }
#pragma unroll
          for (int pp = 0; pp < 4; ++pp) { const int kidx = ((p0 + pp) * 8 + F.wave) * 8 + kq; float s = 0.f;
#pragma unroll
              for (int e = 0; e < 4; ++e) s += (qv[4 * e] * kv[pp][e].x + qv[4 * e + 1] * kv[pp][e].y) + (qv[4 * e + 2] * kv[pp][e].z + qv[4 * e + 3] * kv[pp][e].w);
              s += __shfl_xor(s, 1); s += __shfl_xor(s, 2); s += __shfl_xor(s, 4);
              s *= att::SCALE; if (sub == 0) sc[kidx] = s; smax = fmaxf(smax, s); } }
      if (F.tid == 0) { float s = 0.f; for (int d = 0; d < 128; ++d) s += q[d] * kn[d]; s *= att::SCALE; sc[768] = s; smax = fmaxf(smax, s); } }
    smax = wave_max(smax); if (F.lane == 0) redm[F.wave] = smax;
    LDS_WAIT(); __syncthreads();
    float mx = redm[0];
#pragma unroll
    for (int w = 1; w < 8; ++w) mx = fmaxf(mx, redm[w]);
    __syncthreads();
    float psum = 0.f;
    for (int kidx = F.tid; kidx < 769; kidx += NTHR) { const float p = __expf(sc[kidx] - mx); sc[kidx] = p; psum += p; }
    psum = wave_sum(psum); if (F.lane == 0) redm[8 + F.wave] = psum;
    LDS_WAIT(); __syncthreads();
    float tot = 0.f;
#pragma unroll
    for (int w = 0; w < 8; ++w) tot += redm[8 + w];
    {
        const int d4 = F.tid & 31, kg = F.tid >> 5; f32x4 a = {0.f, 0.f, 0.f, 0.f};
        for (int k0 = 0; k0 < 48; k0 += 16) {
            f32x4 vv[16];
#pragma unroll
            for (int e = 0; e < 16; ++e) { const int kidx = kg * 48 + k0 + e; vv[e] = *(const f32x4*)(F.cache_v + ((size_t)pgs[kidx >> 7] * PAGE + (kidx & 127)) * 1024 + h * 128 + d4 * 4); }
#pragma unroll
            for (int e = 0; e < 16; ++e) a += vv[e] * sc[kg * 48 + k0 + e];
        }
        *(LAS f32x4*)(oacc + kg * 128 + d4 * 4) = a;
    }
    LDS_WAIT(); __syncthreads();
    if (F.tid < 128) { const int d = F.tid; float a = sc[768] * ZS[ZC_VB + h * 128 + d];
#pragma unroll
        for (int g16 = 0; g16 < 16; ++g16) a += oacc[g16 * 128 + d];
        a = a / tot * siluf_(ZS[ZC_GB + h * 128 + d]);
        ((bf16_t*)(F.ws + WS_OB))[(size_t)(MP + b) * 1024 + h * 128 + d] = (bf16_t)(cvt_pk_bf16(a, a) & 0xffffu); }
    __syncthreads();
}
__device__ __forceinline__ void sample_wkv_unit(Frame& F, int unit, LAS float* scr  ) {
    const int b = unit >> 4, h = unit & 15, j = F.lane, hc = h * 64 + j;
    const float* zc = (const float*)(F.ws + WS_ZS) + (size_t)b * ZLD; const float* zp = (const float*)(F.ws + WS_ZS) + (size_t)(8 + b) * ZLD;
#define LERP1(zcol, muoff) (zc[zcol] + (zp[zcol] - zc[zcol]) * F.mu[muoff])
    const float r = LERP1(ZC_R + hc, hc), k = LERP1(ZC_K + hc, 1088 + hc), v = LERP1(ZC_V + hc, 2112 + hc), g = LERP1(ZC_G + hc, 3200 + hc);
    const float twl = tanhf(LERP1(ZC_WLO + j, 1024 + j)), alo = LERP1(ZC_ALO + j, 3136 + j);
#undef LERP1
    float wl = F.w0[hc], aa = F.a0[hc];
    {
        float wv[64];
#pragma unroll
        for (int m = 0; m < 64; ++m) wv[m] = F.w2[(size_t)m * DA + hc];
#pragma unroll
        for (int m = 0; m < 64; ++m) wl += __shfl(twl, m) * wv[m];
#pragma unroll
        for (int m = 0; m < 64; ++m) wv[m] = F.a2[(size_t)m * DA + hc];
#pragma unroll
        for (int m = 0; m < 64; ++m) aa += __shfl(alo, m) * wv[m];
    }
    const float dec = __expf(-0.6065306597126334f * sigmoidf_(wl)), a = sigmoidf_(aa);
    float kk = k * F.k_k[hc]; const float nrm = fmaxf(sqrtf(wave_sum(kk * kk)), 1e-12f); kk = kk / nrm;
    const float kt = k * (1.0f + (a - 1.0f) * F.k_a[hc]), bb = kk * a;
    const float bon = wave_sum(r * kt * F.r_k[hc]);
    scr[j] = dec; scr[64 + j] = kk; scr[128 + j] = bb; scr[192 + j] = kt; scr[256 + j] = r;
    LDS_WAIT(); asm volatile("" ::: "memory");
    const float* Sg = F.st_wkv + ((size_t)(b * 16 + h) * 64 + j) * 64; float* So = F.out + O_WKS + ((size_t)(b * 16 + h) * 64 + j) * 64;
    float S[64];
#pragma unroll
    for (int c4 = 0; c4 < 16; ++c4) { const f32x4 t = *(const f32x4*)(Sg + c4 * 4); S[c4 * 4] = t.x; S[c4 * 4 + 1] = t.y; S[c4 * 4 + 2] = t.z; S[c4 * 4 + 3] = t.w; }
    float sa = 0.f;
#pragma unroll
    for (int c = 0; c < 64; ++c) sa -= S[c] * scr[64 + c];
    float y = 0.f;
#pragma unroll
    for (int c = 0; c < 64; ++c) { S[c] = S[c] * scr[c] + sa * scr[128 + c] + v * scr[192 + c]; y += S[c] * scr[256 + c]; }
#pragma unroll
    for (int c4 = 0; c4 < 16; ++c4) *(f32x4*)(So + c4 * 4) = (f32x4){S[c4 * 4], S[c4 * 4 + 1], S[c4 * 4 + 2], S[c4 * 4 + 3]};
    const float mean = wave_sum(y) * (1.f / 64.f), d = y - mean, var = wave_sum(d * d) * (1.f / 64.f);
    const float yn = d * (1.0f / sqrtf(var + GN_EPS)) * F.lnx_w[hc] + F.lnx_b[hc];
    const float ov = (yn + bon * v) * siluf_(g);
    ((bf16_t*)(F.ws + WS_OA))[(size_t)(MP + b) * 1024 + hc] = (bf16_t)(cvt_pk_bf16(ov, ov) & 0xffffu);
    LDS_WAIT(); asm volatile("" ::: "memory");
}

__device__ __forceinline__ void phase_merge_sample(Frame& F) {
    LAS bf16_t* As = (LAS bf16_t*)F.lds; LAS bf16_t* Bs = As + 16 * (DA + 8);
    stage_rows16<DA>((const bf16_t*)(F.ws + WS_OA) + (size_t)MP * 1024, As, F.tid); stage_rows16<DBB>((const bf16_t*)(F.ws + WS_OB) + (size_t)MP * 1024, Bs, F.tid);
    LDS_WAIT(); __syncthreads();
    const float* ZS = (const float*)(F.ws + WS_ZS); bf16_t* MG = (bf16_t*)(F.ws + WS_MRG) + (size_t)MP * DM;
    const int gw = F.bid * NWAVES + F.wave, NGW = F.G * NWAVES;
    for (int tile = gw; tile < DM / 16; tile += NGW) {
        const f32x4 a = skinny_tile<DA>(As, DA + 8, (const bf16_t*)(F.ws + WS_PAT), tile * 16, F.lane);
        const f32x4 c = skinny_tile<DBB>(Bs, DBB + 8, (const bf16_t*)(F.ws + WS_PBT), tile * 16, F.lane);
        const int q = F.lane >> 4, n = tile * 16 + (F.lane & 15);
        if (q < 2) {
#pragma unroll
            for (int r = 0; r < 4; ++r) { const int m = 4 * q + r; const float ga = sigmoidf_(ZS[(size_t)m * ZLD + ZC_GATE + n]), gb = sigmoidf_(ZS[(size_t)m * ZLD + ZC_GATE + DM + n]);
                const float v = ga * a[r] + gb * c[r]; MG[(size_t)m * DM + n] = (bf16_t)(cvt_pk_bf16(v, v) & 0xffffu); } }
    }
    __syncthreads();
}
__device__ __forceinline__ void phase_out_sample(Frame& F) {
    LAS bf16_t* As = (LAS bf16_t*)F.lds;
    stage_rows16<DM>((const bf16_t*)(F.ws + WS_MRG) + (size_t)MP * DM, As, F.tid);
    LDS_WAIT(); __syncthreads();
    const int gw = F.bid * NWAVES + F.wave, NGW = F.G * NWAVES;
    for (int tile = gw; tile < DM / 16; tile += NGW) {
        const f32x4 a = skinny_tile<DM>(As, DM + 8, (const bf16_t*)(F.ws + WS_WOT), tile * 16, F.lane);
        const int q = F.lane >> 4, n = tile * 16 + (F.lane & 15);
        if (q < 2) {
#pragma unroll
            for (int r = 0; r < 4; ++r) { const int m = 4 * q + r; F.out[O_YS + (size_t)m * DM + n] = F.x_s[(size_t)m * DM + n] + a[r]; } }
    }
    __syncthreads();
}
__device__ __forceinline__ void final_norm_row(Frame& F, float* rowp) {
    f32x4* xr = (f32x4*)rowp + F.lane; const f32x4* wr = (const f32x4*)F.final_w + F.lane;
    f32x4 v[8]; float s = 0.f;
#pragma unroll
    for (int j = 0; j < 8; ++j) { v[j] = xr[64 * j]; s += (v[j].x * v[j].x + v[j].y * v[j].y) + (v[j].z * v[j].z + v[j].w * v[j].w); }
    const float rstd = 1.0f / sqrtf(wave_sum(s) * (1.f / DM) + NORM_EPS);
#pragma unroll
    for (int j = 0; j < 8; ++j) xr[64 * j] = v[j] * rstd * wr[64 * j];
}
namespace wkv {
constexpr int PITCH = 72, SLOT = 64 * PITCH * 2;
constexpr int S_KQ = 0, S_RQ = 1, S_V = 2, S_BBAR = 3, S_KBAR = 4, S_BK = 5, S_KK = 6, S_M = 7, S_N = 8, S_AY = 9, S_BY = 10, S_X0 = 11, S_NV = 12, S_W2 = 13, S_A2 = 14;
constexpr int OFF_RED = 15 * SLOT;
constexpr size_t UNIT_E = 64 * 64;
__device__ __forceinline__ LAS bf16_t* slot(LAS unsigned char* lds, int s) { return (LAS bf16_t*)(lds + s * SLOT); }
__device__ __forceinline__ void frag_row(const LAS bf16_t* img, int r0, int lane, bf16x8 (&f)[2]) {
    const LAS bf16_t* p = img + (r0 + (lane & 15)) * PITCH + 8 * (lane >> 4);
    f[0] = *(const LAS bf16x8*)p; f[1] = *(const LAS bf16x8*)(p + 32);
}
__device__ __forceinline__ void frag_tr(const LAS bf16_t* img, int n0, int lane, bf16x8 (&f)[2]) {
    const int q = lane >> 4, idx = lane & 15;
    const unsigned a = (unsigned)(uintptr_t)(img + (8 * q + (idx >> 2)) * PITCH + n0 + 4 * (idx & 3));
    s16x4 x0, x1, x2, x3;
    asm volatile("ds_read_b64_tr_b16 %0, %1" : "=&v"(x0) : "v"(a) : "memory");
    asm volatile("ds_read_b64_tr_b16 %0, %1 offset:%2" : "=&v"(x1) : "v"(a), "i"(4 * PITCH * 2) : "memory");
    asm volatile("ds_read_b64_tr_b16 %0, %1 offset:%2" : "=&v"(x2) : "v"(a), "i"(32 * PITCH * 2) : "memory");
    asm volatile("ds_read_b64_tr_b16 %0, %1 offset:%2" : "=&v"(x3) : "v"(a), "i"(36 * PITCH * 2) : "memory");
    asm volatile("s_waitcnt lgkmcnt(0)" : "+v"(x0), "+v"(x1), "+v"(x2), "+v"(x3) :: "memory");
    f[0] = (bf16x8){x0[0], x0[1], x0[2], x0[3], x1[0], x1[1], x1[2], x1[3]};
    f[1] = (bf16x8){x2[0], x2[1], x2[2], x2[3], x3[0], x3[1], x3[2], x3[3]};
}
template <bool SWAP> __device__ __forceinline__ void mma(const bf16x8 (&a)[2], const bf16x8 (&b)[2], f32x4& acc) {
#pragma unroll
    for (int ks = 0; ks < 2; ++ks) acc = SWAP ? __builtin_amdgcn_mfma_f32_16x16x32_bf16(b[ks], a[ks], acc, 0, 0, 0) : __builtin_amdgcn_mfma_f32_16x16x32_bf16(a[ks], b[ks], acc, 0, 0, 0);
}
__device__ __forceinline__ void mfma_fence(f32x4& v) { asm volatile("s_nop 7\n\ts_nop 7" : "+v"(v)); }
__device__ __forceinline__ u32x2 pack4(f32x4 v) { u32x2 w; w.x = cvt_pk_bf16(v[0], v[1]); w.y = cvt_pk_bf16(v[2], v[3]); return w; }
__device__ __forceinline__ f32x4 unpack4(u32x2 w) { return (f32x4){bflo(w.x), bfhi(w.x), bflo(w.y), bfhi(w.y)}; }
__device__ __forceinline__ void st_img(LAS bf16_t* img, int m0, int n0, int lane, f32x4 v) { mfma_fence(v); *(LAS u32x2*)(img + (m0 + (lane & 15)) * PITCH + n0 + 4 * (lane >> 4)) = pack4(v); }
__device__ __forceinline__ f32x4 ld_img(const LAS bf16_t* img, int m0, int n0, int lane) { return unpack4(*(const LAS u32x2*)(img + (m0 + (lane & 15)) * PITCH + n0 + 4 * (lane >> 4))); }
#define WKV_BAR() do { asm volatile("s_waitcnt lgkmcnt(0)" ::: "memory"); __builtin_amdgcn_s_barrier(); asm volatile("" ::: "memory"); } while (0)

struct TrRaw { s16x4 x0, x1, x2, x3; };
__device__ __forceinline__ void tr_issue(const LAS bf16_t* img, int n0, int lane, TrRaw& t) {
    const int q = lane >> 4, idx = lane & 15;
    const unsigned a = (unsigned)(uintptr_t)(img + (8 * q + (idx >> 2)) * PITCH + n0 + 4 * (idx & 3));
    asm volatile("ds_read_b64_tr_b16 %0, %1" : "=&v"(t.x0) : "v"(a) : "memory");
    asm volatile("ds_read_b64_tr_b16 %0, %1 offset:%2" : "=&v"(t.x1) : "v"(a), "i"(4 * PITCH * 2) : "memory");
    asm volatile("ds_read_b64_tr_b16 %0, %1 offset:%2" : "=&v"(t.x2) : "v"(a), "i"(32 * PITCH * 2) : "memory");
    asm volatile("ds_read_b64_tr_b16 %0, %1 offset:%2" : "=&v"(t.x3) : "v"(a), "i"(36 * PITCH * 2) : "memory");
}
#define TRV(t) "+v"(t.x0), "+v"(t.x1), "+v"(t.x2), "+v"(t.x3)
#define TR_WAIT2(a, b) asm volatile("s_waitcnt lgkmcnt(0)" : TRV(a), TRV(b) :: "memory")
#define TR_WAIT4(a, b, c, d) asm volatile("s_waitcnt lgkmcnt(0)" : TRV(a), TRV(b), TRV(c), TRV(d) :: "memory")
#define TR_WAIT6(a, b, c, d, e, f) asm volatile("s_waitcnt lgkmcnt(0)" : TRV(a), TRV(b), TRV(c), TRV(d), TRV(e), TRV(f) :: "memory")
#define TR_WAIT7(a, b, c, d, e, f, g) asm volatile("s_waitcnt lgkmcnt(0)" : TRV(a), TRV(b), TRV(c), TRV(d), TRV(e), TRV(f), TRV(g) :: "memory")
__device__ __forceinline__ void tr_frag(const TrRaw& t, bf16x8 (&f)[2]) {
    f[0] = (bf16x8){t.x0[0], t.x0[1], t.x0[2], t.x0[3], t.x1[0], t.x1[1], t.x1[2], t.x1[3]};
    f[1] = (bf16x8){t.x2[0], t.x2[1], t.x2[2], t.x2[3], t.x3[0], t.x3[1], t.x3[2], t.x3[3]};
}
constexpr int OFF_CST = OFF_RED + 4352;
constexpr int STP = 392;
__device__ __forceinline__ void st_fetch(const bf16_t* Z, int b, int h, int c, int tid, u32x4 (&pf)[7]) {
    const bf16_t* zb = Z + ((size_t)b * TSEQ + (size_t)c * 64) * ZLD;
#pragma unroll
    for (int i = 0; i < 7; ++i) { const int idx = tid + NTHR * i; pf[i] = (u32x4){0u, 0u, 0u, 0u};
        if (idx < 65 * 48) { const int rw = idx / 48, rem = idx - rw * 48, reg = rem >> 3, ch = rem & 7;
            const int col = (reg < 4) ? (reg * 1024 + h * 64) : (reg == 4 ? ZC_WLO : ZC_ALO);
            if (rw > 0 || c > 0) pf[i] = *(const u32x4*)(zb + ((ptrdiff_t)rw - 1) * ZLD + col + ch * 8); } }
}
__device__ __forceinline__ void scanA_unit(Frame& F, int bh, int c, bool load_w, u32x4 (&pf)[7], int nbh, int nc, bool has_next, const float* kmsrc, float* kmdst) {
    int tid = F.tid; asm volatile("" : "+v"(tid));
    const int lane = tid & 63, wv = F.wave, tt = lane, cg = wv;
    const int b = bh >> 4, h = bh & 15;
    const size_t uid = (size_t)bh * 64 + c;
    LAS unsigned char* L = F.lds;
    LAS float* red = (LAS float*)(L + OFF_RED); LAS float* red2 = red + 512; LAS float* gC = red2 + 512; LAS float* cst = (LAS float*)(L + OFF_CST);
    LAS float* WLf = (LAS float*)(L + S_X0 * SLOT); LAS float* AAf = (LAS float*)(L + S_M * SLOT);
    const bf16_t* Z = (const bf16_t*)(F.ws + WS_Z);
    if (load_w) {
        const int m = tid >> 3, j = (tid & 7) * 8; float t8[8];
        ld8f(F.w2 + (size_t)m * DA + h * 64 + j, t8); *(LAS u32x4*)(slot(L, S_W2) + m * PITCH + j) = (u32x4){cvt_pk_bf16(t8[0], t8[1]), cvt_pk_bf16(t8[2], t8[3]), cvt_pk_bf16(t8[4], t8[5]), cvt_pk_bf16(t8[6], t8[7])};
        ld8f(F.a2 + (size_t)m * DA + h * 64 + j, t8); *(LAS u32x4*)(slot(L, S_A2) + m * PITCH + j) = (u32x4){cvt_pk_bf16(t8[0], t8[1]), cvt_pk_bf16(t8[2], t8[3]), cvt_pk_bf16(t8[4], t8[5]), cvt_pk_bf16(t8[6], t8[7])};
#pragma unroll
        for (int i = 0; i < 2; ++i) { const int idx = tid + NTHR * i;
            if (idx < 11 * 64) { const int k = idx >> 6, jj = idx & 63, hj = h * 64 + jj; float v;
                switch (k) { case 0: v = F.mu[hj]; break; case 1: v = F.mu[1088 + hj]; break; case 2: v = F.mu[2112 + hj]; break; case 3: v = F.mu[3200 + hj]; break;
                             case 4: v = F.mu[1024 + jj]; break; case 5: v = F.mu[3136 + jj]; break; case 6: v = F.w0[hj]; break; case 7: v = F.a0[hj]; break;
                             case 8: v = F.k_k[hj]; break; case 9: v = F.k_a[hj]; break; default: v = F.r_k[hj]; break; }
                cst[idx] = v; } }
    }
    LAS bf16_t* ST = (LAS bf16_t*)L;
#pragma unroll
    for (int i = 0; i < 7; ++i) { const int idx = tid + NTHR * i;
        if (idx < 65 * 48) { const int rw = idx / 48, rem = idx - rw * 48, reg = rem >> 3, ch = rem & 7; *(LAS u32x4*)(ST + rw * STP + reg * 64 + ch * 8) = pf[i]; } }
    f32x4 kst[8], kacc = {0.f, 0.f, 0.f, 0.f};
#define KM_ISSUE(bt) do { _Pragma("unroll") for (int i = 0; i < 8; ++i) kst[i] = __builtin_nontemporal_load((const f32x4*)(kmsrc + (size_t)(16 * (bt) + 2 * i) * 1024)); } while (0)
#define KM_SUM() do { _Pragma("unroll") for (int i = 0; i < 8; ++i) kacc += kst[i]; } while (0)
    KM_ISSUE(0);
    WKV_BAR();
    float r8[8], k8[8], v8[8], g8[8];
#define LERP8(dst, reg_) do { float cur_[8], prv_[8], mu_[8]; ld8bf_lds(ST + (tt + 1) * STP + (reg_) * 64 + cg * 8, cur_); ld8bf_lds(ST + tt * STP + (reg_) * 64 + cg * 8, prv_); ld8f_lds(cst + (reg_) * 64 + cg * 8, mu_); \
        _Pragma("unroll") for (int e = 0; e < 8; ++e) dst[e] = cur_[e] + (prv_[e] - cur_[e]) * mu_[e]; } while (0)
    LERP8(r8, 0); LERP8(k8, 1); LERP8(v8, 2); LERP8(g8, 3);
    float wl8[8], al8[8]; LERP8(wl8, 4); LERP8(al8, 5);
#undef LERP8
#pragma unroll
    for (int e = 0; e < 8; ++e) wl8[e] = 1.0f - 2.0f * __builtin_amdgcn_rcpf(1.0f + __builtin_amdgcn_exp2f(2.8853900817779268f * wl8[e]));
    *(LAS u32x4*)(slot(L, S_AY) + tt * PITCH + cg * 8) = (u32x4){cvt_pk_bf16(wl8[0], wl8[1]), cvt_pk_bf16(wl8[2], wl8[3]), cvt_pk_bf16(wl8[4], wl8[5]), cvt_pk_bf16(wl8[6], wl8[7])};
    *(LAS u32x4*)(slot(L, S_BY) + tt * PITCH + cg * 8) = (u32x4){cvt_pk_bf16(al8[0], al8[1]), cvt_pk_bf16(al8[2], al8[3]), cvt_pk_bf16(al8[4], al8[5]), cvt_pk_bf16(al8[6], al8[7])};
    float kk[8];
    { float kkc[8]; ld8f_lds(cst + 8 * 64 + cg * 8, kkc); float ss = 0.f;
#pragma unroll
      for (int e = 0; e < 8; ++e) { kk[e] = k8[e] * kkc[e]; ss += kk[e] * kk[e]; }
      red[tt * 8 + cg] = ss; }
    WKV_BAR();
    const int mt = wv & 3, ntp = wv >> 2, m0 = mt * 16, n0 = ntp * 32;
    { bf16x8 a[2], a2[2], b0[2], b1[2]; TrRaw t0, t1, t2, t3;
      frag_row(slot(L, S_AY), m0, lane, a); frag_row(slot(L, S_BY), m0, lane, a2);
      tr_issue(slot(L, S_W2), n0, lane, t0); tr_issue(slot(L, S_W2), n0 + 16, lane, t1); tr_issue(slot(L, S_A2), n0, lane, t2); tr_issue(slot(L, S_A2), n0 + 16, lane, t3);
      TR_WAIT4(t0, t1, t2, t3);
      f32x4 c0 = {0.f, 0.f, 0.f, 0.f}, c1 = c0, d0 = c0, d1 = c0;
      tr_frag(t0, b0); tr_frag(t1, b1); mma<true>(a, b0, c0); mma<true>(a, b1, c1);
      tr_frag(t2, b0); tr_frag(t3, b1); mma<true>(a2, b0, d0); mma<true>(a2, b1, d1);
      const int rr = m0 + (lane & 15), cc = n0 + 4 * (lane >> 4);
      *(LAS f32x4*)(WLf + rr * 68 + cc) = c0; *(LAS f32x4*)(WLf + rr * 68 + cc + 16) = c1;
      *(LAS f32x4*)(AAf + rr * 68 + cc) = d0; *(LAS f32x4*)(AAf + rr * 68 + cc + 16) = d1; }
    WKV_BAR();
    KM_SUM();
    float bon_part;
    { float wl[8], aa[8], t8[8];
      ld8f_lds(cst + 6 * 64 + cg * 8, t8);
#pragma unroll
      for (int e = 0; e < 8; ++e) wl[e] = t8[e] + WLf[tt * 68 + cg * 8 + e];
      ld8f_lds(cst + 7 * 64 + cg * 8, t8);
#pragma unroll
      for (int e = 0; e < 8; ++e) aa[e] = t8[e] + AAf[tt * 68 + cg * 8 + e];
      float tot = 0.f;
#pragma unroll
      for (int e = 0; e < 8; ++e) tot += red[tt * 8 + e];
      const float inv = 1.0f / fmaxf(sqrtf(tot), 1e-12f);
      float kac[8], rkc[8]; ld8f_lds(cst + 9 * 64 + cg * 8, kac); ld8f_lds(cst + 10 * 64 + cg * 8, rkc);
      float ew[8], cum[8], av[8], kt[8], bb[8];
      bon_part = 0.f;
#pragma unroll
      for (int e = 0; e < 8; ++e) { ew[e] = 0.6065306597126334f * sigmoidf_(wl[e]); cum[e] = ew[e]; av[e] = sigmoidf_(aa[e]); kk[e] *= inv;
          kt[e] = k8[e] * (1.0f + (av[e] - 1.0f) * kac[e]); bb[e] = kk[e] * av[e]; bon_part += r8[e] * kt[e] * rkc[e]; }
#pragma unroll
      for (int off = 1; off < 64; off <<= 1) {
#pragma unroll
          for (int e = 0; e < 8; ++e) { const float up = __shfl_up(cum[e], off); cum[e] += (lane >= off) ? up : 0.f; } }
      float okq[8], orq[8], obk[8], okk[8], okb[8], obb[8];
#pragma unroll
      for (int e = 0; e < 8; ++e) { const float Lc = cum[e], LC = __shfl(cum[e], 63);
          const float ein = __expf(-Lc), eex = __expf(ew[e] - Lc), epl = __expf(Lc), erem = __expf(Lc - LC);
          okq[e] = kk[e] * eex; orq[e] = r8[e] * ein; obk[e] = bb[e] * epl; okk[e] = kt[e] * epl; okb[e] = kt[e] * erem; obb[e] = bb[e] * erem;
          if (tt == 0) gC[cg * 8 + e] = __expf(-LC); }
#define ST8(slot_, arr) *(LAS u32x4*)(slot(L, slot_) + tt * PITCH + cg * 8) = (u32x4){cvt_pk_bf16(arr[0], arr[1]), cvt_pk_bf16(arr[2], arr[3]), cvt_pk_bf16(arr[4], arr[5]), cvt_pk_bf16(arr[6], arr[7])}
      ST8(S_KQ, okq); ST8(S_RQ, orq); ST8(S_BK, obk); ST8(S_KK, okk); ST8(S_KBAR, okb); ST8(S_BBAR, obb); ST8(S_V, v8);
#undef ST8
      red2[tt * 8 + cg] = bon_part; }
    WKV_BAR();
    if (has_next) st_fetch(Z, nbh >> 4, nbh & 15, nc, tid, pf);
    KM_ISSUE(1);
    { float bt = 0.f;
#pragma unroll
      for (int e = 0; e < 8; ++e) bt += red2[tt * 8 + e];
      bf16_t* BV = (bf16_t*)(F.ws + WS_CBV) + uid * UNIT_E + tt * 64 + cg * 8; bf16_t* SG = (bf16_t*)(F.ws + WS_CSG) + uid * UNIT_E + tt * 64 + cg * 8;
      *(u32x4*)BV = (u32x4){cvt_pk_bf16(bt * v8[0], bt * v8[1]), cvt_pk_bf16(bt * v8[2], bt * v8[3]), cvt_pk_bf16(bt * v8[4], bt * v8[5]), cvt_pk_bf16(bt * v8[6], bt * v8[7])};
      *(u32x4*)SG = (u32x4){cvt_pk_bf16(siluf_(g8[0]), siluf_(g8[1])), cvt_pk_bf16(siluf_(g8[2]), siluf_(g8[3])), cvt_pk_bf16(siluf_(g8[4]), siluf_(g8[5])), cvt_pk_bf16(siluf_(g8[6]), siluf_(g8[7]))}; }
    const int tr_ = m0 + (lane & 15), sc0 = n0 + 4 * (lane >> 4);
    { bf16x8 akq[2], arq[2], bbk0[2], bbk1[2], bkk0[2], bkk1[2];
      frag_row(slot(L, S_KQ), m0, lane, akq); frag_row(slot(L, S_RQ), m0, lane, arq);
      frag_row(slot(L, S_BK), n0, lane, bbk0); frag_row(slot(L, S_BK), n0 + 16, lane, bbk1); frag_row(slot(L, S_KK), n0, lane, bkk0); frag_row(slot(L, S_KK), n0 + 16, lane, bkk1);
      f32x4 z = {0.f, 0.f, 0.f, 0.f}; f32x4 m_0 = z, m_1 = z, n_0 = z, n_1 = z, ay0 = z, ay1 = z, by0 = z, by1 = z;
      mma<true>(akq, bbk0, m_0); mma<true>(akq, bbk1, m_1); mma<true>(akq, bkk0, n_0); mma<true>(akq, bkk1, n_1);
      mma<true>(arq, bkk0, ay0); mma<true>(arq, bkk1, ay1); mma<true>(arq, bbk0, by0); mma<true>(arq, bbk1, by1);
      f32x4 x0, x1;
#pragma unroll
      for (int r = 0; r < 4; ++r) { const int s0 = sc0 + r, s1 = sc0 + 16 + r;
          m_0[r] = (s0 < tr_) ? m_0[r] : 0.f; m_1[r] = (s1 < tr_) ? m_1[r] : 0.f; n_0[r] = (s0 < tr_) ? n_0[r] : 0.f; n_1[r] = (s1 < tr_) ? n_1[r] : 0.f;
          ay0[r] = (s0 <= tr_) ? ay0[r] : 0.f; ay1[r] = (s1 <= tr_) ? ay1[r] : 0.f; by0[r] = (s0 <= tr_) ? by0[r] : 0.f; by1[r] = (s1 <= tr_) ? by1[r] : 0.f;
          x0[r] = ((s0 == tr_) ? 1.f : 0.f) - m_0[r]; x1[r] = ((s1 == tr_) ? 1.f : 0.f) - m_1[r]; }
      st_img(slot(L, S_M), m0, n0, lane, m_0); st_img(slot(L, S_M), m0, n0 + 16, lane, m_1); st_img(slot(L, S_N), m0, n0, lane, n_0); st_img(slot(L, S_N), m0, n0 + 16, lane, n_1);
      st_img(slot(L, S_AY), m0, n0, lane, ay0); st_img(slot(L, S_AY), m0, n0 + 16, lane, ay1); st_img(slot(L, S_BY), m0, n0, lane, by0); st_img(slot(L, S_BY), m0, n0 + 16, lane, by1);
      st_img(slot(L, S_X0), m0, n0, lane, x0); st_img(slot(L, S_X0), m0, n0 + 16, lane, x1); }
    WKV_BAR();
#define NEUMANN_ROUND(PIN, POUT, XIN, XOUT, DO_P, DO_X, DO_NV) do {                                                           \
        bf16x8 ap[2], ax[2], an[2], bp0[2], bp1[2], bv0[2], bv1[2]; TrRaw tp0, tp1, tv0, tv1; f32x4 x0, x1;                       \
        if (DO_P) frag_row(slot(L, PIN), m0, lane, ap);                                                                         \
        if (DO_X) { frag_row(slot(L, XIN), m0, lane, ax); x0 = ld_img(slot(L, XIN), m0, n0, lane); x1 = ld_img(slot(L, XIN), m0, n0 + 16, lane); } \
        if (DO_NV) frag_row(slot(L, S_N), m0, lane, an);                                                                        \
        tr_issue(slot(L, PIN), n0, lane, tp0); tr_issue(slot(L, PIN), n0 + 16, lane, tp1);                                      \
        if (DO_NV) { tr_issue(slot(L, S_V), n0, lane, tv0); tr_issue(slot(L, S_V), n0 + 16, lane, tv1); TR_WAIT4(tp0, tp1, tv0, tv1); } else { TR_WAIT2(tp0, tp1); } \
        tr_frag(tp0, bp0); tr_frag(tp1, bp1);                                                                                    \
        if (DO_P) { f32x4 p0 = {0.f, 0.f, 0.f, 0.f}, p1 = p0; mma<true>(ap, bp0, p0); mma<true>(ap, bp1, p1);                      \
                    st_img(slot(L, POUT), m0, n0, lane, p0); st_img(slot(L, POUT), m0, n0 + 16, lane, p1); }                      \
        if (DO_X) { mma<true>(ax, bp0, x0); mma<true>(ax, bp1, x1); st_img(slot(L, XOUT), m0, n0, lane, x0); st_img(slot(L, XOUT), m0, n0 + 16, lane, x1); } \
        if (DO_NV) { tr_frag(tv0, bv0); tr_frag(tv1, bv1); f32x4 v0 = {0.f, 0.f, 0.f, 0.f}, v1 = v0; mma<true>(an, bv0, v0); mma<true>(an, bv1, v1); \
                     st_img(slot(L, S_NV), m0, n0, lane, v0); st_img(slot(L, S_NV), m0, n0 + 16, lane, v1); }                       \
        WKV_BAR(); } while (0)
    NEUMANN_ROUND(S_M, S_BK, S_X0, S_X0, true, false, true);
    NEUMANN_ROUND(S_BK, S_M, S_X0, S_KK, true, true, false);
    KM_SUM(); KM_ISSUE(2);
    NEUMANN_ROUND(S_M, S_BK, S_KK, S_X0, true, true, false);
    NEUMANN_ROUND(S_BK, S_M, S_X0, S_KK, true, true, false);
    NEUMANN_ROUND(S_M, S_BK, S_KK, S_X0, true, true, false);
    KM_SUM(); KM_ISSUE(3);
    NEUMANN_ROUND(S_BK, S_M, S_X0, S_KK, false, true, false);
#undef NEUMANN_ROUND
    { bf16x8 at[2], b0[2], b1[2]; TrRaw t0, t1, t2, t3; frag_row(slot(L, S_KK), m0, lane, at);
      tr_issue(slot(L, S_KQ), n0, lane, t0); tr_issue(slot(L, S_KQ), n0 + 16, lane, t1); tr_issue(slot(L, S_NV), n0, lane, t2); tr_issue(slot(L, S_NV), n0 + 16, lane, t3);
      TR_WAIT4(t0, t1, t2, t3);
      tr_frag(t0, b0); tr_frag(t1, b1);
      f32x4 w0 = {0.f, 0.f, 0.f, 0.f}, w1 = w0; mma<true>(at, b0, w0); mma<true>(at, b1, w1);
      st_img(slot(L, S_M), m0, n0, lane, w0); st_img(slot(L, S_M), m0, n0 + 16, lane, w1);
      tr_frag(t2, b0); tr_frag(t3, b1);
      f32x4 u0 = {0.f, 0.f, 0.f, 0.f}, u1 = u0; mma<true>(at, b0, u0); mma<true>(at, b1, u1);
      st_img(slot(L, S_N), m0, n0, lane, -u0); st_img(slot(L, S_N), m0, n0 + 16, lane, -u1); }
    WKV_BAR();
    { const int c16 = lane & 15, q4 = 4 * (lane >> 4);
      bf16x8 a[2], a2[2], b0[2], b1[2], c0[2], c1[2];
      TrRaw tw, tbb0, tbb1, tv, tnu, tkb0, tkb1;
      tr_issue(slot(L, S_M), m0, lane, tw); tr_issue(slot(L, S_BBAR), n0, lane, tbb0); tr_issue(slot(L, S_BBAR), n0 + 16, lane, tbb1);
      tr_issue(slot(L, S_V), m0, lane, tv); tr_issue(slot(L, S_N), m0, lane, tnu); tr_issue(slot(L, S_KBAR), n0, lane, tkb0); tr_issue(slot(L, S_KBAR), n0 + 16, lane, tkb1);
      TR_WAIT7(tw, tbb0, tbb1, tv, tnu, tkb0, tkb1);
      tr_frag(tw, a); tr_frag(tbb0, b0); tr_frag(tbb1, b1);
      { f32x4 p0 = {0.f, 0.f, 0.f, 0.f}, p1 = p0; mma<false>(a, b0, p0); mma<false>(a, b1, p1);
#pragma unroll
        for (int r = 0; r < 4; ++r) { const int j = m0 + q4 + r; const float gd = gC[j]; p0[r] = ((j == n0 + c16) ? gd : 0.f) - p0[r]; p1[r] = ((j == n0 + 16 + c16) ? gd : 0.f) - p1[r]; }
        bf16_t* PT = (bf16_t*)(F.ws + WS_CPM) + uid * UNIT_E;
        *(u32x2*)(PT + (size_t)(n0 + c16) * 64 + m0 + q4) = pack4(p0); *(u32x2*)(PT + (size_t)(n0 + 16 + c16) * 64 + m0 + q4) = pack4(p1); }
      tr_frag(tv, a); tr_frag(tnu, a2); tr_frag(tkb0, c0); tr_frag(tkb1, c1);
      { f32x4 q0 = {0.f, 0.f, 0.f, 0.f}, q1 = q0; mma<true>(a, c0, q0); mma<true>(a, c1, q1); mma<true>(a2, b0, q0); mma<true>(a2, b1, q1);
        float* QG = (float*)(F.ws + WS_CQ) + uid * UNIT_E + (size_t)(m0 + c16) * 64 + n0 + q4; *(f32x4*)QG = q0; *(f32x4*)(QG + 16) = q1; }
      TrRaw tw0, tw1, tv0, tv1, tn0, tn1;
      frag_row(slot(L, S_BY), m0, lane, a); frag_row(slot(L, S_AY), m0, lane, a2);
      const f32x4 r0 = ld_img(slot(L, S_RQ), m0, n0, lane), r1 = ld_img(slot(L, S_RQ), m0, n0 + 16, lane);
      tr_issue(slot(L, S_M), n0, lane, tw0); tr_issue(slot(L, S_M), n0 + 16, lane, tw1); tr_issue(slot(L, S_V), n0, lane, tv0); tr_issue(slot(L, S_V), n0 + 16, lane, tv1);
      tr_issue(slot(L, S_N), n0, lane, tn0); tr_issue(slot(L, S_N), n0 + 16, lane, tn1);
      TR_WAIT6(tw0, tw1, tv0, tv1, tn0, tn1);
      tr_frag(tw0, b0); tr_frag(tw1, b1);
      { f32x4 y0 = {0.f, 0.f, 0.f, 0.f}, y1 = y0; mma<true>(a, b0, y0); mma<true>(a, b1, y1);
        bf16_t* YQ = (bf16_t*)(F.ws + WS_CYQ) + uid * UNIT_E + (size_t)(m0 + c16) * 64 + n0 + q4; *(u32x2*)YQ = pack4(r0 - y0); *(u32x2*)(YQ + 16) = pack4(r1 - y1); }
      tr_frag(tv0, b0); tr_frag(tv1, b1); tr_frag(tn0, c0); tr_frag(tn1, c1);
      { f32x4 y0 = {0.f, 0.f, 0.f, 0.f}, y1 = y0; mma<true>(a2, b0, y0); mma<true>(a2, b1, y1); mma<true>(a, c0, y0); mma<true>(a, c1, y1);
        float* YL = (float*)(F.ws + WS_CYL) + uid * UNIT_E + (size_t)(m0 + c16) * 64 + n0 + q4; *(f32x4*)YL = y0; *(f32x4*)(YL + 16) = y1; } }
    KM_SUM();
    *(f32x4*)kmdst = kacc;
#undef KM_ISSUE
#undef KM_SUM
    WKV_BAR();
}

__device__ __forceinline__ void scanB_unit(Frame& F, int unit) {
    int tid = F.tid; asm volatile("" : "+v"(tid));
    const int bh = unit >> 1, half = unit & 1;
    const int lane = tid & 63, wv = F.wave, ml0 = (wv & 1) * 16, m0 = half * 32 + ml0, n0 = (wv >> 1) * 16, c16 = lane & 15, q4 = 4 * (lane >> 4);
    LAS unsigned char* L = F.lds;
    const bf16_t* PT = (const bf16_t*)(F.ws + WS_CPM) + (size_t)bh * 64 * UNIT_E; const float* QG = (const float*)(F.ws + WS_CQ) + (size_t)bh * 64 * UNIT_E;
    bf16_t* SC = (bf16_t*)(F.ws + WS_CSC) + (size_t)bh * 64 * UNIT_E;
    f32x4 s = {0.f, 0.f, 0.f, 0.f};
    const size_t boff = (size_t)(n0 + c16) * 64 + 2 * q4, qoff = (size_t)(m0 + c16) * 64 + n0 + q4;
    bf16x8 P0[2], P1[2], P2[2], P3[2], P4[2], P5[2], P6[2], P7[2]; f32x4 Q0, Q1, Q2, Q3, Q4, Q5, Q6, Q7;
#define SB_LOAD(P, Q, cc) do { const int c_ = (cc) < 64 ? (cc) : 63; const bf16_t* PTn = PT + (size_t)c_ * UNIT_E + boff;                                  \
        P[0] = *(const bf16x8*)PTn; P[1] = *(const bf16x8*)(PTn + 32); Q = *(const f32x4*)(QG + (size_t)c_ * UNIT_E + qoff); } while (0)
#define SB_STEP(cc, P, Q) do { LAS bf16_t* simg = slot(L, (cc) & 1);                                                                                    \
        mfma_fence(s); const u32x2 w = pack4(s);                                                                                                         \
        *(LAS u32x2*)(simg + (ml0 + c16) * PITCH + n0 + q4) = w;                                                                                        \
        *(u32x2*)(SC + (size_t)(cc) * UNIT_E + (size_t)(m0 + c16) * 64 + n0 + q4) = w;                                                                   \
        asm volatile("s_waitcnt lgkmcnt(0)" ::: "memory"); __builtin_amdgcn_s_barrier(); asm volatile("" ::: "memory");                                 \
        bf16x8 a[2]; frag_row(simg, ml0, lane, a);                                                                                                        \
        s = Q; mma<true>(a, P, s);                                                                                                                        \
        SB_LOAD(P, Q, (cc) + 8); } while (0)
    SB_LOAD(P0, Q0, 0); SB_LOAD(P1, Q1, 1); SB_LOAD(P2, Q2, 2); SB_LOAD(P3, Q3, 3); SB_LOAD(P4, Q4, 4); SB_LOAD(P5, Q5, 5); SB_LOAD(P6, Q6, 6); SB_LOAD(P7, Q7, 7);
    for (int c = 0; c < 64; c += 8) {
        SB_STEP(c, P0, Q0); SB_STEP(c + 1, P1, Q1); SB_STEP(c + 2, P2, Q2); SB_STEP(c + 3, P3, Q3);
        SB_STEP(c + 4, P4, Q4); SB_STEP(c + 5, P5, Q5); SB_STEP(c + 6, P6, Q6); SB_STEP(c + 7, P7, Q7);
    }
#undef SB_LOAD
#undef SB_STEP
    mfma_fence(s);
    *(f32x4*)(F.out + O_WKP + (size_t)bh * 4096 + (size_t)(m0 + c16) * 64 + n0 + q4) = s;
    WKV_BAR();
}

__device__ __forceinline__ void scanC_unit(Frame& F, int bh, int c) {
    int tid = F.tid; asm volatile("" : "+v"(tid));
    const int lane = tid & 63, wv = F.wave, mt = wv & 3, ntp = wv >> 2, m0 = mt * 16, n0 = ntp * 32, c16 = lane & 15, q4 = 4 * (lane >> 4);
    const size_t uid = (size_t)bh * 64 + c; const int b = bh >> 4, h = bh & 15;
    LAS float* Yf = (LAS float*)F.lds;
    const bf16_t* YQ = (const bf16_t*)(F.ws + WS_CYQ) + uid * UNIT_E; const bf16_t* SC = (const bf16_t*)(F.ws + WS_CSC) + uid * UNIT_E; const float* YL = (const float*)(F.ws + WS_CYL) + uid * UNIT_E;
    bf16x8 a[2], b0[2], b1[2];
    { const bf16_t* ap = YQ + (size_t)(m0 + c16) * 64 + 2 * q4; a[0] = *(const bf16x8*)ap; a[1] = *(const bf16x8*)(ap + 32);
      const bf16_t* bp = SC + (size_t)(n0 + c16) * 64 + 2 * q4; b0[0] = *(const bf16x8*)bp; b0[1] = *(const bf16x8*)(bp + 32); b1[0] = *(const bf16x8*)(bp + 16 * 64); b1[1] = *(const bf16x8*)(bp + 16 * 64 + 32); }
    f32x4 y0 = *(const f32x4*)(YL + (size_t)(m0 + c16) * 64 + n0 + q4), y1 = *(const f32x4*)(YL + (size_t)(m0 + c16) * 64 + n0 + 16 + q4);
    mma<true>(a, b0, y0); mma<true>(a, b1, y1);
    *(LAS f32x4*)(Yf + (m0 + c16) * 68 + n0 + q4) = y0; *(LAS f32x4*)(Yf + (m0 + c16) * 68 + n0 + 16 + q4) = y1;
    WKV_BAR();
    { const int tt = tid >> 3, ig = tid & 7; float y[8];
      const f32x4 ya = *(const LAS f32x4*)(Yf + tt * 68 + ig * 8), yb = *(const LAS f32x4*)(Yf + tt * 68 + ig * 8 + 4);
      y[0] = ya.x; y[1] = ya.y; y[2] = ya.z; y[3] = ya.w; y[4] = yb.x; y[5] = yb.y; y[6] = yb.z; y[7] = yb.w;
      float s = 0.f;
#pragma unroll
      for (int e = 0; e < 8; ++e) s += y[e];
      s += __shfl_xor(s, 1); s += __shfl_xor(s, 2); s += __shfl_xor(s, 4);
      const float mean = s * (1.f / 64.f); float vq = 0.f;
#pragma unroll
      for (int e = 0; e < 8; ++e) { y[e] -= mean; vq += y[e] * y[e]; }
      vq += __shfl_xor(vq, 1); vq += __shfl_xor(vq, 2); vq += __shfl_xor(vq, 4);
      const float rstd = 1.0f / sqrtf(vq * (1.f / 64.f) + GN_EPS);
      float lw[8], lb[8], bv[8], sg[8];
      ld8f(F.lnx_w + h * 64 + ig * 8, lw); ld8f(F.lnx_b + h * 64 + ig * 8, lb);
      ld8bf((const bf16_t*)(F.ws + WS_CBV) + uid * UNIT_E + tt * 64 + ig * 8, bv); ld8bf((const bf16_t*)(F.ws + WS_CSG) + uid * UNIT_E + tt * 64 + ig * 8, sg);
      float o[8];
#pragma unroll
      for (int e = 0; e < 8; ++e) o[e] = (y[e] * rstd * lw[e] + lb[e] + bv[e]) * sg[e];
      bf16_t* OA = (bf16_t*)(F.ws + WS_OA) + ((size_t)b * TSEQ + c * 64 + tt) * 1024 + h * 64 + ig * 8;
      *(u32x4*)OA = (u32x4){cvt_pk_bf16(o[0], o[1]), cvt_pk_bf16(o[2], o[3]), cvt_pk_bf16(o[4], o[5]), cvt_pk_bf16(o[6], o[7])}; }
    WKV_BAR();
}
}
#ifndef MK_N_LAUNCHES
#define MK_N_LAUNCHES 1
#endif
constexpr int N_PHASES = 8;
#ifndef REP0
#define REP0 1
#endif
#ifndef REP1
#define REP1 1
#endif
#ifndef REP2
#define REP2 1
#endif
#ifndef REP3
#define REP3 1
#endif
#ifndef REP4
#define REP4 1
#endif
#ifndef REP5
#define REP5 1
#endif
#ifndef REP6
#define REP6 1
#endif
__device__ __forceinline__ void phase1(Frame& F) {
    pg8::Gemm g{(const bf16_t*)(F.ws + WS_XN), (const bf16_t*)(F.ws + WS_WINT), MP, ZC_WLO, DM}; pg8::StaticOrder S; S.init(MP, ZC_WLO, F.G, F.bid);
    pg8::EpiIn E{(bf16_t*)(F.ws + WS_Z), F.out + O_KP, F.out + O_VP, (float*)(F.ws + WS_KMP), (const float*)(F.ws + WS_ROPE)};
    pg8::gemm_phase<pg8::EpiIn, pg8::StaticOrder, true, true>(F.lds, g, S, E);
    for (int u = F.bid; u < MP / 32; u += F.G) lora_unit(F, u);
    phase_inproj_sample(F);
}
__device__ __forceinline__ void phase2(Frame& F) {
    { int last_bh = -1; u32x4 pf[7];
      const int cq = F.tid & 255, rg = F.tid >> 8;
      int phys = 0;
      if (F.bid < 2048) { const int j = F.bid & 255, k = F.bid >> 8; wkv::st_fetch((const bf16_t*)(F.ws + WS_Z), (j >> 3) >> 4, (j >> 3) & 15, (j & 7) + 8 * k, F.tid, pf);
          const int uid0 = (j >> 3) * 64 + (j & 7) + 8 * k; phys = F.page_table[uid0 >> 1]; }
      for (int u = F.bid; u < 2048; u += F.G) { const int j = u & 255, k = u >> 8, bh = j >> 3, c = (j & 7) + 8 * k, uid = bh * 64 + c;
          const int un = u + F.G, jn = un & 255, kn = un >> 8, uidn = (jn >> 3) * 64 + (jn & 7) + 8 * kn;
          const int physn = (un < 2048) ? F.page_table[uidn >> 1] : 0;
          const float* kmsrc = F.cache_k + ((size_t)phys * PAGE + (uid & 1) * 64 + rg) * 1024 + cq * 4;
          float* kmdst = (float*)(F.ws + WS_KMS) + ((size_t)uid * 2 + rg) * 1024 + cq * 4;
          wkv::scanA_unit(F, bh, c, bh != last_bh, pf, jn >> 3, (jn & 7) + 8 * kn, un < 2048, kmsrc, kmdst); last_bh = bh; phys = physn; } }
    for (int u = F.bid; u < 240; u += F.G) moba_select_unit(F, u);
}
__device__ __forceinline__ void phase3(Frame& F) {
    moba_past_phase(F);
    __syncthreads();
    for (int u = F.G - 1 - F.bid; u < 64; u += F.G) wkv::scanB_unit(F, u);
    for (int u = ((2 * F.G - 65 - F.bid) % F.G) * NWAVES + F.wave; u < 128; u += F.G * NWAVES) sample_wkv_unit(F, u, (LAS float*)F.lds + 4096 + F.wave * 512);
}
__device__ __forceinline__ void phase4(Frame& F) {
    for (int u = F.bid; u < 2048; u += F.G) wkv::scanC_unit(F, u >> 6, u & 63);
    for (int u = F.bid; u < 256; u += F.G) moba_own(F, u);
    for (int u = F.G - 1 - F.bid; u < 64; u += F.G) sample_attn_unit(F, u);
}
__device__ __forceinline__ void phase5(Frame& F) {
    { pg8::Gemm g{(const bf16_t*)(F.ws + WS_OA), (const bf16_t*)(F.ws + WS_PAT), MP, DM, DA}; pg8::StaticOrder S; S.init(MP, DM, F.G, F.bid);
      pg8::EpiMrgA E{(const bf16_t*)(F.ws + WS_Z), (float*)(F.ws + WS_TMP)};
      pg8::gemm_phase<pg8::EpiMrgA, pg8::StaticOrder, true, true>(F.lds, g, S, E); }
    { pg8::Gemm g{(const bf16_t*)(F.ws + WS_OB), (const bf16_t*)(F.ws + WS_PBT), MP, DM, DBB}; pg8::StaticOrder S; S.init(MP, DM, F.G, F.bid);
      pg8::EpiMrgB E{(const bf16_t*)(F.ws + WS_Z), (const float*)(F.ws + WS_TMP), (bf16_t*)(F.ws + WS_MRG)};
      pg8::gemm_phase<pg8::EpiMrgB, pg8::StaticOrder, true, true>(F.lds, g, S, E); }
    phase_merge_sample(F);
}
__device__ __forceinline__ void phase6(Frame& F) {
    pg8::Gemm g{(const bf16_t*)(F.ws + WS_MRG), (const bf16_t*)(F.ws + WS_WOT), MP, DM, DM}; pg8::StaticOrder S; S.init(MP, DM, F.G, F.bid);
    pg8::EpiRes E{F.x_p, F.out + O_YP};
    pg8::gemm_phase<pg8::EpiRes, pg8::StaticOrder, true, true>(F.lds, g, S, E);
    phase_out_sample(F);
}
__global__ void __launch_bounds__(NTHR, 2) fwd_kernel(Args args) {
    extern __shared__ __attribute__((aligned(16))) unsigned char lds[];
    Frame F;
    F.lds = (LAS unsigned char*)lds; F.ldsg = (char*)lds;
    F.tid = threadIdx.x; F.lane = F.tid & 63; F.wave = __builtin_amdgcn_readfirstlane(F.tid >> 6); F.G = gridDim.x; F.bid = blockIdx.x;
    F.x_p = (const float*)args.in[0]; F.x_s = (const float*)args.in[1]; F.st_shift = (const float*)args.in[2]; F.st_wkv = (const float*)args.in[3];
    F.cache_k = (const float*)args.in[4]; F.cache_v = (const float*)args.in[5]; F.page_table = (const int*)args.in[6];
    F.ln_w = (const float*)args.in[7]; F.w_in = (const float*)args.in[8]; F.mu = (const float*)args.in[9]; F.w0 = (const float*)args.in[10]; F.w2 = (const float*)args.in[11];
    F.a0 = (const float*)args.in[12]; F.a2 = (const float*)args.in[13]; F.k_k = (const float*)args.in[14]; F.k_a = (const float*)args.in[15]; F.r_k = (const float*)args.in[16];
    F.lnx_w = (const float*)args.in[17]; F.lnx_b = (const float*)args.in[18]; F.p_a = (const float*)args.in[19]; F.p_b = (const float*)args.in[20]; F.w_o = (const float*)args.in[21];
    F.final_w = (const float*)args.in[22]; F.out = args.out; F.ws = args.ws;
    volatile LAS unsigned* MISC = (volatile LAS unsigned*)(F.lds + MISC_OFF);
    for (int u = F.tid; u < (LDS_BYTES - LDSCTL_OFF) / 4; u += NTHR) ((LAS unsigned*)(F.lds + LDSCTL_OFF))[u] = 0u;
    __syncthreads();
    const int lo = args.ph_lo, hi = args.ph_hi;
    XcdBarrier bar; bar.bar = (unsigned*)(F.ws + WS_CTL) + CW_BAR; bar.x = 0; bar.st = MISC + 8;
    if (hi - lo > 1) bar = xcd_barrier_post((unsigned*)(F.ws + WS_CTL) + CW_BAR, MISC + 8);
#define IN(k) (lo <= (k) && (k) < hi)
#define SEAM(k) do { if (IN(k) && IN((k) + 1)) xcd_barrier(bar); } while (0)

    if (IN(0)) { phase_prologue(F); if (REP0 > 1) { xcd_barrier(bar); phase_prologue(F); } }
    SEAM(0);
    if (IN(1)) { phase1(F); if (REP1 > 1) { xcd_barrier(bar); phase1(F); } }
    SEAM(1);
    if (IN(2)) { phase2(F); if (REP2 > 1) { xcd_barrier(bar); phase2(F); } }
    SEAM(2);
    if (IN(3)) { phase3(F); if (REP3 > 1) { xcd_barrier(bar); phase3(F); } }
    SEAM(3);
    if (IN(4)) { phase4(F); if (REP4 > 1) { xcd_barrier(bar); phase4(F); } }
    SEAM(4);
    if (IN(5)) { phase5(F); if (REP5 > 1) { xcd_barrier(bar); phase5(F); } }
    SEAM(5);
    if (IN(6)) { phase6(F); if (REP6 > 1) { xcd_barrier(bar); phase6(F); } }
    SEAM(6);
    if (IN(7)) {
        for (int r = F.bid * NWAVES + F.wave; r < MP + DECB; r += F.G * NWAVES) final_norm_row(F, r < MP ? F.out + O_YP + (size_t)r * DM : F.out + O_YS + (size_t)(r - MP) * DM);
    }
#undef IN
#undef SEAM
}

extern "C" void kernel_launch(void* const* d_in, const int* in_sizes, int n_in, void* d_out, int out_size, void* d_ws, size_t ws_size, hipStream_t stream) {
    static int grid = 0;
    if (grid == 0) {
        if (n_in != 23 || (size_t)out_size != O_END || ws_size < WS_END) { fprintf(stderr, "kernel_launch: unexpected shapes: n_in %d out %d ws %zu; nothing launched\n", n_in, out_size, ws_size); grid = -1; return; }
        int dev = 0, cus = 0, per_cu = 0;
        if (hipGetDevice(&dev) != hipSuccess || hipDeviceGetAttribute(&cus, hipDeviceAttributeMultiprocessorCount, dev) != hipSuccess) { grid = -1; return; }
        if (hipFuncSetAttribute((const void*)fwd_kernel, hipFuncAttributeMaxDynamicSharedMemorySize, LDS_BYTES) != hipSuccess) { fprintf(stderr, "kernel_launch: hipFuncSetAttribute failed\n"); grid = -1; return; }
        if (hipOccupancyMaxActiveBlocksPerMultiprocessor(&per_cu, (const void*)fwd_kernel, NTHR, LDS_BYTES) != hipSuccess || per_cu < 1)
            fprintf(stderr, "kernel_launch: note: occupancy query reports %d workgroups per CU\n", per_cu);
        (void)hipGetLastError();
        grid = cus;
    }
    if (grid < 0) return;
    if (hipMemsetAsync((char*)d_ws + WS_CTL, 0, CTL_ZERO_BYTES, stream) != hipSuccess) { fprintf(stderr, "kernel_launch: memset failed\n"); return; }
    Args a{};
    for (int i = 0; i < 23; ++i) a.in[i] = d_in[i];
    a.out = (float*)d_out; a.ws = (unsigned char*)d_ws;
    constexpr int NL = MK_N_LAUNCHES;
    for (int li = 0; li < NL; ++li) {
        a.ph_lo = li * N_PHASES / NL; a.ph_hi = (li + 1) * N_PHASES / NL;
        hipLaunchKernelGGL(fwd_kernel, dim3(grid), dim3(NTHR), LDS_BYTES, stream, a);
        const hipError_t le = hipPeekAtLastError();
        if (le != hipSuccess) { fprintf(stderr, "kernel_launch: launch %d failed: %s\n", li, hipGetErrorName(le)); break; }
    }
}
```

```cpp
#include <hip/hip_runtime.h>
#include <cstdio>
#include <cstdint>

#define GAS __attribute__((address_space(1)))
#define LAS __attribute__((address_space(3)))
typedef unsigned short bf16_t;
typedef short bf16x8 __attribute__((ext_vector_type(8)));
typedef short s16x4 __attribute__((ext_vector_type(4)));
typedef float f32x2 __attribute__((ext_vector_type(2)));
typedef float f32x4 __attribute__((ext_vector_type(4)));
typedef float f32x16 __attribute__((ext_vector_type(16)));
typedef unsigned u32x2 __attribute__((ext_vector_type(2)));
typedef unsigned u32x4 __attribute__((ext_vector_type(4)));

constexpr int DM = 2048, NBATCH = 2, TSEQ = 4096, MP = NBATCH * TSEQ;
constexpr int DECB = 8, PAST = 16384, PAGE = 128, NPG = PAST / PAGE;
constexpr int DA = 1024, HA = 16, NA = 64;
constexpr int DBB = 1024, HB = 8, HD = 128;
constexpr int NIN = 12416, ZLD = 12544;
constexpr int RWC = 4224;
constexpr int ZC_R = 0, ZC_K = 1024, ZC_V = 2048, ZC_G = 3072, ZC_Q = 4096, ZC_KB = 5120, ZC_VB = 6144, ZC_GB = 7168, ZC_GATE = 8192, ZC_WLO = 12288, ZC_ALO = 12352;
constexpr size_t O_YP = 0, O_YS = 16777216, O_SHP = O_YS + 16384, O_WKP = O_SHP + 4096, O_KP = O_WKP + 131072, O_VP = O_KP + 8388608,
                 O_SHS = O_VP + 8388608, O_WKS = O_SHS + 16384, O_KS = O_WKS + 524288, O_VS = O_KS + 8192, O_END = O_VS + 8192;
constexpr float NORM_EPS = 1e-6f, GN_EPS = 64e-5f;

__host__ __device__ inline int zcol_to_src(int c) {
    if (c < 1024) return c;
    if (c < 2048) return 1088 + (c - 1024);
    if (c < 3072) return 2112 + (c - 2048);
    if (c < 4096) return 3200 + (c - 3072);
    if (c < 8192) return 4224 + (c - 4096);
    if (c < 12288) return 8320 + (c - 8192);
    if (c < 12352) return 1024 + (c - 12288);
    if (c < 12416) return 3136 + (c - 12352);
    return -1;
}

__host__ __device__ inline int perm32inv(int c) { return 16 * ((c >> 2) & 1) + 4 * (c >> 3) + (c & 3); }
__host__ __device__ inline int wrow(int c) { const int l = c & 255; return (c & ~255) + 128 * ((l >> 5) & 1) + 32 * (l >> 6) + perm32inv(l & 31); }
__host__ __device__ inline int wrow_in(int c) { return c < 12288 ? wrow(c) : c; }

__device__ __forceinline__ unsigned cvt_pk_bf16(float lo, float hi) { unsigned r; asm volatile("v_cvt_pk_bf16_f32 %0, %1, %2" : "=v"(r) : "v"(lo), "v"(hi)); return r; }
__device__ __forceinline__ float bf2f(unsigned short b) { return __uint_as_float(((unsigned)b) << 16); }
__device__ __forceinline__ float bflo(unsigned w) { return __uint_as_float(w << 16); }
__device__ __forceinline__ float bfhi(unsigned w) { return __uint_as_float(w & 0xffff0000u); }
__device__ __forceinline__ float sigmoidf_(float x) { return __builtin_amdgcn_rcpf(1.0f + __builtin_amdgcn_exp2f(-1.4426950408889634f * x)); }
__device__ __forceinline__ float siluf_(float x) { return x * sigmoidf_(x); }
__device__ __forceinline__ float wave_sum(float v) {
#pragma unroll
    for (int o = 1; o < 64; o <<= 1) v += __shfl_xor(v, o);
    return v;
}
__device__ __forceinline__ float wave_max(float v) {
#pragma unroll
    for (int o = 1; o < 64; o <<= 1) v = fmaxf(v, __shfl_xor(v, o));
    return v;
}
__device__ __forceinline__ void mfma_fence4(f32x4& v) { asm volatile("s_nop 7\n\ts_nop 7" : "+v"(v)); }
#define LDS_WAIT() asm volatile("s_waitcnt lgkmcnt(0)" ::: "memory")
#define VM_WAIT() asm volatile("s_waitcnt vmcnt(0)" ::: "memory")
__device__ __forceinline__ void ld8bf(const bf16_t* p, float (&o)[8]) {
    const u32x4 w = *(const u32x4*)p;
    o[0] = bflo(w.x); o[1] = bfhi(w.x); o[2] = bflo(w.y); o[3] = bfhi(w.y); o[4] = bflo(w.z); o[5] = bfhi(w.z); o[6] = bflo(w.w); o[7] = bfhi(w.w);
}
__device__ __forceinline__ void ld8bf_lds(const LAS bf16_t* p, float (&o)[8]) {
    const u32x4 w = *(const LAS u32x4*)p;
    o[0] = bflo(w.x); o[1] = bfhi(w.x); o[2] = bflo(w.y); o[3] = bfhi(w.y); o[4] = bflo(w.z); o[5] = bfhi(w.z); o[6] = bflo(w.w); o[7] = bfhi(w.w);
}
__device__ __forceinline__ void ld8f(const float* p, float (&o)[8]) {
    const f32x4 a = *(const f32x4*)p, b = *(const f32x4*)(p + 4);
    o[0] = a.x; o[1] = a.y; o[2] = a.z; o[3] = a.w; o[4] = b.x; o[5] = b.y; o[6] = b.z; o[7] = b.w;
}
__device__ __forceinline__ void ld8f_lds(const LAS float* p, float (&o)[8]) {
    const f32x4 a = *(const LAS f32x4*)p, b = *(const LAS f32x4*)(p + 4);
    o[0] = a.x; o[1] = a.y; o[2] = a.z; o[3] = a.w; o[4] = b.x; o[5] = b.y; o[6] = b.z; o[7] = b.w;
}
__device__ __forceinline__ void st8f(float* p, const float (&o)[8]) {
    *(f32x4*)p = (f32x4){o[0], o[1], o[2], o[3]}; *(f32x4*)(p + 4) = (f32x4){o[4], o[5], o[6], o[7]};
}
namespace pg8 {
#define PG8_LAS __attribute__((address_space(3)))
typedef unsigned short bf16_t;
typedef short bf16x8 __attribute__((ext_vector_type(8)));
typedef float f32x4 __attribute__((ext_vector_type(4)));
typedef unsigned u32x4 __attribute__((ext_vector_type(4)));
constexpr int BM = 256, BK = 64, HALF = 128, HTB = HALF * BK * 2  , STAGE_BYTES = 8 * HTB, NXCD = 8, WGM = 8;

__host__ __device__ __forceinline__ int lds_byte(int r, int c) { const int st = (r >> 4) * 2 + (c >> 5), rr = r & 15, cc = c & 31, ob = rr * 64 + cc * 2; return st * 1024 + (ob ^ (((ob >> 9) & 1) << 5)); }
__host__ __device__ __forceinline__ void stage_rc(int b, int& R, int& C) { const int st = b / 1024, sb = b % 1024, swz = sb ^ (((sb >> 9) & 1) << 5); R = (st >> 1) * 16 + swz / 64; C = (st & 1) * 32 + (swz % 64) / 2; }
__host__ __device__ __forceinline__ int perm32(int rho) { const int n = rho >> 4, i = rho & 15; return 8 * (i >> 2) + 4 * n + (i & 3); }

struct Unit { int pm, pn; };
struct Gemm { const bf16_t* A; const bf16_t* Bt; int M, N, K; };

struct StaticOrder {
    int nM, nN, nwg, G, c;
    __host__ __device__ void init(int M, int N, int G_, int c_) { nM = M / BM; nN = N / BM; nwg = nM * nN; G = G_; c = c_; }
    __host__ __device__ bool next(int i, Unit& u) const {
        const long L = (long)i * G + c; if (L >= nwg) return false;
        int wgid = (int)L; { const int q = nwg / NXCD, r = nwg % NXCD, xcd = wgid % NXCD, off = wgid / NXCD; wgid = (xcd < r ? xcd * (q + 1) : r * (q + 1) + (xcd - r) * q) + off; }
        const int nig = WGM * nN, gid = wgid / nig, fm = gid * WGM, gsz = (nM - fm) < WGM ? (nM - fm) : WGM;
        u.pm = fm + ((wgid % nig) % gsz); u.pn = (wgid % nig) / gsz; return true;
    }
    __device__ __forceinline__ void a_ready(const Unit&) const {}
    __device__ __forceinline__ void done(const Unit&) const {}
};
__device__ __forceinline__ u32x4 pk8(f32x4 a, f32x4 b) { u32x4 w; w.x = cvt_pk_bf16(a[0], a[1]); w.y = cvt_pk_bf16(a[2], a[3]); w.z = cvt_pk_bf16(b[0], b[1]); w.w = cvt_pk_bf16(b[2], b[3]); return w; }
struct EpiIn {
    static constexpr bool PERM = false, AFTER_DRAIN = false;
    bf16_t* Z; float* kout; float* vout; float* kmp; const float* rope;
    __device__ __forceinline__ void operator()(const f32x4 (&acc)[2][2][4][2], const Unit& u, int wr, int wc, int fr, int fq) const {
        const int pn = u.pn, row0 = u.pm * BM + wr * 64 + fr, col0 = pn * BM + wc * 64 + 8 * fq;
        const bool is_rope = (pn >= 16 && pn < 24) && ((wc & 1) == 0);
        const bool is_k = (pn >= 20 && pn < 24), is_v = (pn >= 24 && pn < 28), is_silu = (pn >= 28 && pn < 32), is_sig = (pn >= 32 && pn < 48);
        float* fout = is_k ? kout : vout; const int fcol0 = (pn - (is_k ? 20 : 24)) * BM + wc * 64 + 8 * fq;
        const float rsgn = (fq < 2) ? -1.0f : 1.0f;
        f32x4 ks[2][2];
#pragma unroll
        for (int bj = 0; bj < 2; ++bj)
#pragma unroll
            for (int n = 0; n < 2; ++n) ks[bj][n] = (f32x4){0.f, 0.f, 0.f, 0.f};
#pragma unroll
        for (int ai = 0; ai < 2; ++ai)
#pragma unroll
            for (int m = 0; m < 4; ++m) {
                const int row = row0 + ai * HALF + m * 16;
                bf16_t* zrow = Z + (size_t)row * ZLD + col0;
#pragma unroll
                for (int bj = 0; bj < 2; ++bj) {
                    f32x4 v0 = acc[ai][bj][m][0], v1 = acc[ai][bj][m][1];
                    if (bj == 0 && is_rope) {
                        const float* rp = rope + (size_t)(row & 4095) * 32 + 8 * (fq & 1);
                        const f32x4 c0 = *(const f32x4*)rp, c1 = *(const f32x4*)(rp + 4), s0 = *(const f32x4*)(rp + 16), s1 = *(const f32x4*)(rp + 20);
                        f32x4 o0, o1;
#pragma unroll
                        for (int j = 0; j < 4; ++j) { o0[j] = __shfl_xor(v0[j], 32); o1[j] = __shfl_xor(v1[j], 32); }
                        v0 = v0 * c0 + o0 * s0 * rsgn; v1 = v1 * c1 + o1 * s1 * rsgn;
                    }
                    if (is_silu) {
#pragma unroll
                        for (int j = 0; j < 4; ++j) { v0[j] = siluf_(v0[j]); v1[j] = siluf_(v1[j]); } }
                    if (is_sig) {
#pragma unroll
                        for (int j = 0; j < 4; ++j) { v0[j] = sigmoidf_(v0[j]); v1[j] = sigmoidf_(v1[j]); } }
                    *(u32x4*)(zrow + bj * 32) = pk8(v0, v1);
                    if (is_k || is_v) { float* fp = fout + (size_t)row * 1024 + fcol0 + bj * 32; *(f32x4*)fp = v0; *(f32x4*)(fp + 4) = v1; }
                    if (is_k) { ks[bj][0] += v0; ks[bj][1] += v1; }
                }
            }
        if (is_k) {
#pragma unroll
            for (int bj = 0; bj < 2; ++bj)
#pragma unroll
                for (int n = 0; n < 2; ++n) {
                    f32x4 s = ks[bj][n];
#pragma unroll
                    for (int o = 1; o < 16; o <<= 1) { s[0] += __shfl_xor(s[0], o); s[1] += __shfl_xor(s[1], o); s[2] += __shfl_xor(s[2], o); s[3] += __shfl_xor(s[3], o); }
                    if (fr == 0) *(f32x4*)(kmp + (size_t)(u.pm * 2 + wr) * 1024 + fcol0 + bj * 32 + n * 4) = s;
                }
        }
    }
};
struct EpiMrgA {
    static constexpr bool PERM = false, AFTER_DRAIN = false;
    const bf16_t* Z; float* tmp;
    __device__ __forceinline__ void operator()(const f32x4 (&acc)[2][2][4][2], const Unit& u, int wr, int wc, int fr, int fq) const {
        const int row0 = u.pm * BM + wr * 64 + fr, col0 = u.pn * BM + wc * 64 + 8 * fq;
#pragma unroll
        for (int ai = 0; ai < 2; ++ai)
#pragma unroll
            for (int m = 0; m < 4; ++m) { const int row = row0 + ai * HALF + m * 16; const bf16_t* gp = Z + (size_t)row * ZLD + ZC_GATE + col0; float* tp = tmp + (size_t)row * DM + col0;
#pragma unroll
                for (int bj = 0; bj < 2; ++bj) { const u32x4 g = *(const u32x4*)(gp + bj * 32); const f32x4 a = acc[ai][bj][m][0], b = acc[ai][bj][m][1];
                    *(f32x4*)(tp + bj * 32) = (f32x4){a[0] * bflo(g.x), a[1] * bfhi(g.x), a[2] * bflo(g.y), a[3] * bfhi(g.y)};
                    *(f32x4*)(tp + bj * 32 + 4) = (f32x4){b[0] * bflo(g.z), b[1] * bfhi(g.z), b[2] * bflo(g.w), b[3] * bfhi(g.w)}; } }
    }
};
struct EpiMrgB {
    static constexpr bool PERM = false, AFTER_DRAIN = false;
    const bf16_t* Z; const float* tmp; bf16_t* mrg;
    __device__ __forceinline__ void operator()(const f32x4 (&acc)[2][2][4][2], const Unit& u, int wr, int wc, int fr, int fq) const {
        const int row0 = u.pm * BM + wr * 64 + fr, col0 = u.pn * BM + wc * 64 + 8 * fq;
#pragma unroll
        for (int ai = 0; ai < 2; ++ai)
#pragma unroll
            for (int m = 0; m < 4; ++m) { const int row = row0 + ai * HALF + m * 16; const bf16_t* gp = Z + (size_t)row * ZLD + ZC_GATE + DM + col0; const float* tp = tmp + (size_t)row * DM + col0;
                bf16_t* op = mrg + (size_t)row * DM + col0;
#pragma unroll
                for (int bj = 0; bj < 2; ++bj) { const u32x4 g = *(const u32x4*)(gp + bj * 32); const f32x4 a = acc[ai][bj][m][0], b = acc[ai][bj][m][1];
                    const f32x4 t0 = *(const f32x4*)(tp + bj * 32), t1 = *(const f32x4*)(tp + bj * 32 + 4);
                    const f32x4 r0 = (f32x4){t0[0] + a[0] * bflo(g.x), t0[1] + a[1] * bfhi(g.x), t0[2] + a[2] * bflo(g.y), t0[3] + a[3] * bfhi(g.y)};
                    const f32x4 r1 = (f32x4){t1[0] + b[0] * bflo(g.z), t1[1] + b[1] * bfhi(g.z), t1[2] + b[2] * bflo(g.w), t1[3] + b[3] * bfhi(g.w)};
                    *(u32x4*)(op + bj * 32) = pk8(r0, r1); } }
    }
};
struct EpiRes {
    static constexpr bool PERM = false, AFTER_DRAIN = false;
    const float* x; float* out;
    __device__ __forceinline__ void operator()(const f32x4 (&acc)[2][2][4][2], const Unit& u, int wr, int wc, int fr, int fq) const {
        const int row0 = u.pm * BM + wr * 64 + fr, col0 = u.pn * BM + wc * 64 + 8 * fq;
#pragma unroll
        for (int ai = 0; ai < 2; ++ai)
#pragma unroll
            for (int m = 0; m < 4; ++m) { const size_t off = (size_t)(row0 + ai * HALF + m * 16) * DM + col0;
#pragma unroll
                for (int bj = 0; bj < 2; ++bj) { *(f32x4*)(out + off + bj * 32) = *(const f32x4*)(x + off + bj * 32) + acc[ai][bj][m][0]; *(f32x4*)(out + off + bj * 32 + 4) = *(const f32x4*)(x + off + bj * 32 + 4) + acc[ai][bj][m][1]; } }
    }
};
template <class Epi, class Sched, bool ALIGN_EPI = false, bool SP2 = false>
__device__ __forceinline__ void gemm_phase(PG8_LAS unsigned char* lds, const Gemm g, const Sched& S, const Epi& E) {
    const int tid = threadIdx.x, wid = __builtin_amdgcn_readfirstlane(tid >> 6), lane = tid & 63, wr = wid >> 2, wc = wid & 3, fr = lane & 15, fq = lane >> 4;
    const int K = g.K, nt = K / BK;
    unsigned voffA[2], voffB[2];
#pragma unroll
    for (int i = 0; i < 2; ++i) { int R, C; stage_rc(tid * 16 + i * 8192, R, C); const int Rb = Epi::PERM ? ((R & ~31) + perm32(R & 31)) : R;
        voffA[i] = (unsigned)(R * K + C) * 2u; voffB[i] = (unsigned)(Rb * K + C) * 2u; }
    const size_t kstep = (size_t)(BK * 2);
    const size_t hstep = (size_t)HALF * K * 2;
    const size_t tstep = 2 * hstep;
    const unsigned ldsw = (unsigned)wid * 1024u;
    const int aoff = lds_byte(wr * 64 + fr, fq * 8), boff = lds_byte(wc * 32 + fr, fq * 8);
#define PG8_SA(b, h) (((b) * 2 + (h)) * HTB)
#define PG8_SB(b, h) ((4 + (b) * 2 + (h)) * HTB)
#define PG8_STAGE(bufoff, gbase, voff) do { _Pragma("unroll") for (int _i = 0; _i < 2; ++_i) \
        __builtin_amdgcn_global_load_lds((const unsigned*)((const char*)(gbase) + (voff)[_i]), (PG8_LAS unsigned*)(lds + (bufoff) + ldsw + _i * 8192), 16, 0, 0); } while (0)
#define PG8_LDA(dst, b, h) do { _Pragma("unroll") for (int m = 0; m < 4; ++m) _Pragma("unroll") for (int k = 0; k < 2; ++k) dst[m][k] = *(const PG8_LAS bf16x8*)(lds + PG8_SA(b, h) + aoff + m * 2048 + k * 1024); } while (0)
#define PG8_LDB(dst, b, h) do { _Pragma("unroll") for (int n = 0; n < 2; ++n) _Pragma("unroll") for (int k = 0; k < 2; ++k) dst[n][k] = *(const PG8_LAS bf16x8*)(lds + PG8_SB(b, h) + boff + n * 2048 + k * 1024); } while (0)
#define PG8_MMA(ai, bj, At, Bt) do { __builtin_amdgcn_s_setprio(1); _Pragma("unroll") for (int m = 0; m < 4; ++m) _Pragma("unroll") for (int n = 0; n < 2; ++n) _Pragma("unroll") for (int k = 0; k < 2; ++k) \
        acc[ai][bj][m][n] = __builtin_amdgcn_mfma_f32_16x16x32_bf16(Bt[n][k], At[m][k], acc[ai][bj][m][n], 0, 0, 0); __builtin_amdgcn_s_setprio(0); } while (0)
#define PG8_WAIT_V(n) asm volatile("s_waitcnt vmcnt(" #n ")" ::: "memory")
#define PG8_WAIT_L(n) asm volatile("s_waitcnt lgkmcnt(" #n ")" ::: "memory")
#define PG8_BAR __builtin_amdgcn_s_barrier()
#define PG8_SCHED __builtin_amdgcn_sched_barrier(0)
    Unit cur, nxt; int ui = 0;
    if (!S.next(0, cur)) return;
    f32x4 acc[2][2][4][2];
#pragma unroll
    for (int a = 0; a < 2; ++a)
#pragma unroll
        for (int b = 0; b < 2; ++b)
#pragma unroll
            for (int m = 0; m < 4; ++m)
#pragma unroll
                for (int n = 0; n < 2; ++n) acc[a][b][m][n] = (f32x4){0.f, 0.f, 0.f, 0.f};
    bf16x8 At[4][2], B0[2][2], B1[2][2];
    const char* cA = (const char*)g.A + (size_t)cur.pm * tstep; const char* cB = (const char*)g.Bt + (size_t)cur.pn * tstep;
    S.a_ready(cur);
    if constexpr (SP2) {
        PG8_STAGE(PG8_SB(0, 0), cB, voffB); PG8_STAGE(PG8_SB(0, 1), cB + hstep, voffB); PG8_STAGE(PG8_SA(0, 0), cA, voffA); PG8_STAGE(PG8_SA(0, 1), cA + hstep, voffA);
        if (wr == 1) PG8_BAR;
        PG8_WAIT_V(2); PG8_BAR;
        PG8_STAGE(PG8_SB(1, 0), cB + kstep, voffB); PG8_STAGE(PG8_SA(1, 0), cA + kstep, voffA); PG8_STAGE(PG8_SB(1, 1), cB + hstep + kstep, voffB);
        PG8_WAIT_V(6); PG8_BAR;
    } else {
        PG8_STAGE(PG8_SB(0, 0), cB, voffB); PG8_STAGE(PG8_SA(0, 0), cA, voffA); PG8_STAGE(PG8_SB(0, 1), cB + hstep, voffB); PG8_STAGE(PG8_SA(0, 1), cA + hstep, voffA);
        if (wr == 1) PG8_BAR;
        PG8_WAIT_V(4); PG8_BAR;
        PG8_STAGE(PG8_SB(1, 0), cB + kstep, voffB); PG8_STAGE(PG8_SA(1, 0), cA + kstep, voffA); PG8_STAGE(PG8_SB(1, 1), cB + hstep + kstep, voffB);
        PG8_WAIT_V(6); PG8_BAR;
    }
    for (;;) {
        const bool has_next = S.next(ui + 1, nxt);
        const char* nA = has_next ? (const char*)g.A + (size_t)nxt.pm * tstep : cA; const char* nB = has_next ? (const char*)g.Bt + (size_t)nxt.pn * tstep : cB;
        for (int t = 0; t < nt; t += 2) {
            const bool last = (t == nt - 2);
            const char* a1 = cA + (size_t)(t + 1) * kstep;
            const char* a2 = last ? nA : cA + (size_t)(t + 2) * kstep; const char* b2 = last ? nB : cB + (size_t)(t + 2) * kstep;
            const char* a3 = a2 + kstep; const char* b3 = b2 + kstep;
            if (last && has_next) S.a_ready(nxt);
            if constexpr (SP2) {
            PG8_LDB(B0, 0, 0); PG8_LDB(B1, 0, 1); PG8_SCHED; PG8_LDA(At, 0, 0); PG8_STAGE(PG8_SA(1, 1), a1 + hstep, voffA);
            PG8_WAIT_V(8); PG8_WAIT_L(0); PG8_BAR; PG8_MMA(0, 0, At, B0); PG8_MMA(0, 1, At, B1); PG8_BAR; PG8_SCHED;
            PG8_LDA(At, 0, 1); PG8_STAGE(PG8_SB(0, 0), b2, voffB); PG8_STAGE(PG8_SB(0, 1), b2 + hstep, voffB); PG8_STAGE(PG8_SA(0, 0), a2, voffA);
            PG8_WAIT_V(8); PG8_WAIT_L(0); PG8_BAR; PG8_MMA(1, 0, At, B0); PG8_MMA(1, 1, At, B1); PG8_BAR; PG8_SCHED;
            PG8_LDB(B0, 1, 0); PG8_LDB(B1, 1, 1); PG8_SCHED; PG8_LDA(At, 1, 0); PG8_STAGE(PG8_SA(0, 1), a2 + hstep, voffA);
            PG8_WAIT_V(8); PG8_WAIT_L(0); PG8_BAR; PG8_MMA(0, 0, At, B0); PG8_MMA(0, 1, At, B1); PG8_BAR; PG8_SCHED;
            PG8_LDA(At, 1, 1); PG8_STAGE(PG8_SB(1, 0), b3, voffB); PG8_STAGE(PG8_SB(1, 1), b3 + hstep, voffB); PG8_STAGE(PG8_SA(1, 0), a3, voffA);
            PG8_WAIT_V(8); PG8_WAIT_L(0); PG8_BAR; PG8_MMA(1, 0, At, B0); PG8_MMA(1, 1, At, B1); PG8_BAR; PG8_SCHED;
            } else {
            PG8_LDB(B0, 0, 0); PG8_SCHED; PG8_LDA(At, 0, 0); PG8_STAGE(PG8_SA(1, 1), a1 + hstep, voffA);
            PG8_WAIT_L(8); PG8_BAR; PG8_WAIT_L(0); PG8_MMA(0, 0, At, B0); PG8_BAR; PG8_SCHED;
            PG8_LDB(B1, 0, 1); PG8_STAGE(PG8_SB(0, 0), b2, voffB);
            PG8_BAR; PG8_WAIT_L(0); PG8_MMA(0, 1, At, B1); PG8_BAR;
            PG8_LDA(At, 0, 1); PG8_STAGE(PG8_SA(0, 0), a2, voffA);
            PG8_BAR; PG8_WAIT_L(0); PG8_MMA(1, 0, At, B0); PG8_BAR; PG8_SCHED;
            PG8_STAGE(PG8_SB(0, 1), b2 + hstep, voffB);
            PG8_WAIT_V(6); PG8_BAR; PG8_MMA(1, 1, At, B1); PG8_BAR;
            PG8_LDB(B0, 1, 0); PG8_SCHED; PG8_LDA(At, 1, 0); PG8_STAGE(PG8_SA(0, 1), a2 + hstep, voffA);
            PG8_WAIT_L(8); PG8_BAR; PG8_WAIT_L(0); PG8_MMA(0, 0, At, B0); PG8_BAR; PG8_SCHED;
            PG8_LDB(B1, 1, 1); PG8_STAGE(PG8_SB(1, 0), b3, voffB);
            PG8_BAR; PG8_WAIT_L(0); PG8_MMA(0, 1, At, B1); PG8_BAR;
            PG8_LDA(At, 1, 1); PG8_STAGE(PG8_SA(1, 0), a3, voffA);
            PG8_BAR; PG8_WAIT_L(0); PG8_MMA(1, 0, At, B0); PG8_BAR; PG8_SCHED;
            PG8_STAGE(PG8_SB(1, 1), b3 + hstep, voffB);
            PG8_WAIT_V(6); PG8_BAR; PG8_MMA(1, 1, At, B1); PG8_BAR;
            }
        }
        if constexpr (ALIGN_EPI) { if (wr == 0) PG8_BAR; }
        if constexpr (!Epi::AFTER_DRAIN) { E(acc, cur, wr, wc, fr, fq); S.done(cur); }
        if (!has_next) break;
#pragma unroll
        for (int a = 0; a < 2; ++a)
#pragma unroll
            for (int b = 0; b < 2; ++b)
#pragma unroll
                for (int m = 0; m < 4; ++m)
#pragma unroll
                    for (int n = 0; n < 2; ++n) acc[a][b][m][n] = (f32x4){0.f, 0.f, 0.f, 0.f};
        cur = nxt; cA = nA; cB = nB; ++ui;
        if constexpr (ALIGN_EPI) { if (wr == 1) PG8_BAR; }
    }
    PG8_WAIT_V(0);
    if constexpr (!ALIGN_EPI) { if (wr == 0) PG8_BAR; }
    PG8_BAR;
    if constexpr (Epi::AFTER_DRAIN) { E.fused(acc, cur, wr, wc, fr, fq, lds, wid, lane); S.done(cur); }
#undef PG8_SA
#undef PG8_SB
#undef PG8_STAGE
#undef PG8_LDA
#undef PG8_LDB
#undef PG8_MMA
#undef PG8_WAIT_V
#undef PG8_WAIT_L
#undef PG8_BAR
#undef PG8_SCHED
}

}
namespace att {
constexpr int D = 128;
constexpr float SCALE = 0.08838834764831845f;
constexpr float THR = 8.f;
constexpr int NW = 8, QBLK = 32, KVBLK = 64, QB = NW * QBLK;
constexpr int SHM_V = KVBLK * D * 2, SHM_K = KVBLK * D * 2;
constexpr int ATT_LDS = 2 * SHM_V + 2 * SHM_K + NW * 64 * 4;
#define KSWZ(row, colB) ((row) * 256 + ((colB) ^ (((row) & 7) << 4)))
#define SBAR() __builtin_amdgcn_sched_barrier(0)
__device__ __forceinline__ int v_st(int k, int c) { const int kk = (k & ~0xC) | ((k & 4) << 1) | ((k & 8) >> 1); return ((kk >> 3) * 4 + (c >> 5)) * 512 + ((kk & 7) * 32 + (c & 31)) * 2; }
__device__ __forceinline__ int v_rd_base(int lane) { return ((lane & 3) << 3) | (((lane >> 2) & 3) << 6) | (((lane >> 4) & 1) << 5) | (((lane >> 5) & 1) << 8); }
constexpr int v_rd_off(int d0, int ks, int half) { return d0 * 512 + ks * 4096 + half * 2048; }
__device__ __forceinline__ int crow(int r, int hi) { return (r & 3) + 8 * (r >> 2) + 4 * hi; }
__device__ __forceinline__ unsigned cvtpk(float lo, float hi) { unsigned r; asm volatile("v_cvt_pk_bf16_f32 %0, %1, %2" : "=v"(r) : "v"(lo), "v"(hi)); return r; }
__device__ __forceinline__ bf16x8 ld8(const bf16_t* p) { return *reinterpret_cast<const bf16x8*>(p); }
__device__ __forceinline__ void mask_causal(f32x16& p0, f32x16& p1, int dq) {
    const float NEG = -__builtin_inff();
#pragma unroll
    for (int r = 0; r < 16; ++r) {
        const int c = (r & 3) + 8 * (r >> 2);
        if (dq - c < 0) p0[r] = NEG;
        if (dq - c - 32 < 0) p1[r] = NEG;
    }
}
__device__ __forceinline__ void mask_all(f32x16& p0, f32x16& p1, bool keep) {
    const float NEG = -__builtin_inff();
#pragma unroll
    for (int r = 0; r < 16; ++r) { p0[r] = keep ? p0[r] : NEG; p1[r] = keep ? p1[r] : NEG; }
}
__device__ __forceinline__ void partialSM(f32x16& p0, f32x16& p1, float& m_reg, float& mn, float& alpha) {
    float pmax = p0[0];
#pragma unroll
    for (int r = 1; r < 16; ++r) pmax = fmaxf(pmax, p0[r]);
#pragma unroll
    for (int r = 0; r < 16; ++r) pmax = fmaxf(pmax, p1[r]);
    { auto rr = __builtin_amdgcn_permlane32_swap(__float_as_uint(pmax), __float_as_uint(pmax), false, false);
      pmax = fmaxf(__uint_as_float(rr[0]), __uint_as_float(rr[1])); }
    constexpr float C2 = 1.4426950408889634f * SCALE;
    if (__builtin_expect(__all((pmax - m_reg) * SCALE <= THR), 1)) { mn = m_reg; alpha = 1.f; }
    else { mn = fmaxf(m_reg, pmax); alpha = __builtin_amdgcn_exp2f((m_reg - mn) * C2); m_reg = mn; }
    const float mnL = -mn * C2;
#pragma unroll
    for (int r = 0; r < 16; ++r) p0[r] = fmaf(p0[r], C2, mnL);
#pragma unroll
    for (int r = 0; r < 16; ++r) p1[r] = fmaf(p1[r], C2, mnL);
#pragma unroll
    for (int r = 0; r < 16; ++r) p0[r] = __builtin_amdgcn_exp2f(p0[r]);
}
__device__ __forceinline__ void finishSM(f32x16& p0, f32x16& p1, float alpha, float& l_reg, bf16x8& pa0, bf16x8& pa1, bf16x8& pa2, bf16x8& pa3) {
#pragma unroll
    for (int r = 0; r < 16; ++r) p1[r] = __builtin_amdgcn_exp2f(p1[r]);
    float ps = 0;
#pragma unroll
    for (int r = 0; r < 16; ++r) ps += p0[r];
#pragma unroll
    for (int r = 0; r < 16; ++r) ps += p1[r];
    { auto rr = __builtin_amdgcn_permlane32_swap(__float_as_uint(ps), __float_as_uint(ps), false, false);
      ps = __uint_as_float(rr[0]) + __uint_as_float(rr[1]); }
    l_reg = l_reg * alpha + ps;
#define PK4(P, B_, OUT) do { unsigned a0 = cvtpk(P[B_+0], P[B_+1]), a1 = cvtpk(P[B_+2], P[B_+3]);                          \
        unsigned b0 = cvtpk(P[B_+4], P[B_+5]), b1 = cvtpk(P[B_+6], P[B_+7]);                                             \
        auto r0 = __builtin_amdgcn_permlane32_swap(a0, b0, false, false); auto r1 = __builtin_amdgcn_permlane32_swap(a1, b1, false, false); \
        u32x4 w = {r0[0], r1[0], r0[1], r1[1]}; OUT = *reinterpret_cast<bf16x8*>(&w); } while (0)
    PK4(p0, 0, pa0); PK4(p0, 8, pa1); PK4(p1, 0, pa2); PK4(p1, 8, pa3);
#undef PK4
}
template <int KB>
__device__ __forceinline__ void qkt(f32x16& p0, f32x16& p1, const char* K_lds, int r32, int hi, const bf16x8* qr) {
    p0 = f32x16{}; p1 = f32x16{};
    const char* kb[4];
#pragma unroll
    for (int dd = 0; dd < 4; ++dd) kb[dd] = K_lds + KB * SHM_K + KSWZ(r32, (dd * 16 + hi * 8) * 2);
#pragma unroll
    for (int d0 = 0; d0 < 8; ++d0) { const char* a = kb[d0 & 3] + (d0 >> 2) * 128;
        bf16x8 b0 = *reinterpret_cast<const bf16x8*>(a);
        bf16x8 b1 = *reinterpret_cast<const bf16x8*>(a + 32 * 256);
        p0 = __builtin_amdgcn_mfma_f32_32x32x16_bf16(b0, qr[d0], p0, 0, 0, 0);
        p1 = __builtin_amdgcn_mfma_f32_32x32x16_bf16(b1, qr[d0], p1, 0, 0, 0); }
}
template <int VB>
__device__ __forceinline__ void pv_tile(f32x16* o, int vb0, bf16x8 pa0, bf16x8 pa1, bf16x8 pa2, bf16x8 pa3) {
#define TRRD(dst, off) asm volatile("ds_read_b64_tr_b16 %0, %1 offset:%2" : "=&v"(dst) : "v"(vb0), "i"(off) : "memory")
#define PV_D0(d0) do { s16x4 l0, l1, l2, l3, h0, h1, h2, h3; constexpr int b_ = VB * SHM_V + v_rd_off(d0, 0, 0);     \
        TRRD(l0, b_); TRRD(h0, b_ + 2048); TRRD(l1, b_ + 4096); TRRD(h1, b_ + 6144); TRRD(l2, b_ + 8192); TRRD(h2, b_ + 10240); TRRD(l3, b_ + 12288); TRRD(h3, b_ + 14336); \
        asm volatile("s_waitcnt lgkmcnt(0)" ::: "memory"); SBAR();                                                                \
        o[d0] = __builtin_amdgcn_mfma_f32_32x32x16_bf16(pa0, (bf16x8){l0[0], l0[1], l0[2], l0[3], h0[0], h0[1], h0[2], h0[3]}, o[d0], 0, 0, 0);   \
        o[d0] = __builtin_amdgcn_mfma_f32_32x32x16_bf16(pa1, (bf16x8){l1[0], l1[1], l1[2], l1[3], h1[0], h1[1], h1[2], h1[3]}, o[d0], 0, 0, 0);   \
        o[d0] = __builtin_amdgcn_mfma_f32_32x32x16_bf16(pa2, (bf16x8){l2[0], l2[1], l2[2], l2[3], h2[0], h2[1], h2[2], h2[3]}, o[d0], 0, 0, 0);   \
        o[d0] = __builtin_amdgcn_mfma_f32_32x32x16_bf16(pa3, (bf16x8){l3[0], l3[1], l3[2], l3[3], h3[0], h3[1], h3[2], h3[3]}, o[d0], 0, 0, 0); } while (0)
    PV_D0(0); PV_D0(1); PV_D0(2); PV_D0(3);
#undef PV_D0
#undef TRRD
}
constexpr int LDZ = ZLD, LDO = 1024;
#define ROW(p, k0, rr) ((p) + (size_t)((k0) + (rr)) * LDZ + sc)
#define VMW() asm volatile("s_waitcnt vmcnt(0)" ::: "memory")
#define SLOAD_H(Kp, Vp, k0) do { st_v0 = ld8(ROW(Vp, k0, sr)); st_v1 = ld8(ROW(Vp, k0, 32 + sr));              \
                         st_k0 = ld8(ROW(Kp, k0, sr)); st_k1 = ld8(ROW(Kp, k0, 32 + sr)); } while (0)
#define SWRITE_H(bf) do { *(bf16x8*)(V_lds + (bf) * SHM_V + vst0) = st_v0; *(bf16x8*)(V_lds + (bf) * SHM_V + vst1) = st_v1;      \
                          *(bf16x8*)(K_lds + (bf) * SHM_K + kws) = st_k0; *(bf16x8*)(K_lds + (bf) * SHM_K + kws + 32 * 256) = st_k1; } while (0)
template <bool CAUSAL>
__device__ __forceinline__ void moba_core(const bf16_t* qrow, const bf16_t* Kh, const bf16_t* Vh, int kb0, char* lds, int tid, f32x16 (&o)[4], float& m_reg, float& l_reg) {
    const int wid = __builtin_amdgcn_readfirstlane(tid >> 6), lane = tid & 63, r32 = lane & 31, hi = lane >> 5;
    constexpr int NT = 4;
    const int qlo = wid * QBLK, qm = qlo + r32 - 4 * hi;
    char* V_lds = lds; char* K_lds = lds + 2 * SHM_V;
    float* ws = (float*)(lds + 2 * SHM_V + 2 * SHM_K) + wid * 64; float* al_l = ws + 32;
    m_reg = -1e30f; l_reg = 0;
#pragma unroll
    for (int d = 0; d < 4; ++d) o[d] = f32x16{};
    const int sr = tid >> 4, sc = (tid & 15) * 8, vst0 = v_st(sr, sc), vst1 = v_st(32 + sr, sc), kws = KSWZ(sr, sc * 2);
    const int vb0 = (int)(uintptr_t)V_lds + v_rd_base(lane);
    bf16x8 qr[8], st_v0, st_v1, st_k0, st_k1;
#pragma unroll
    for (int d0 = 0; d0 < 8; ++d0) qr[d0] = ld8(qrow + d0 * 16 + hi * 8);
    SLOAD_H(Kh, Vh, kb0); VMW(); SWRITE_H(0);
    __syncthreads();
#define RESC(a) do { if (__any((a) < 1.f)) { if (hi == 0) al_l[r32] = (a); asm volatile("s_waitcnt lgkmcnt(0)" ::: "memory");              \
                     for (int d_ = 0; d_ < 4; ++d_) for (int r = 0; r < 16; ++r) o[d_][r] *= al_l[crow(r, hi)]; } } while (0)
#define TILE_STEP(t, BUF) do { f32x16 p0, p1; float mn, al; bf16x8 pa0, pa1, pa2, pa3;                                         \
        if ((t) + 1 < NT) { SLOAD_H(Kh, Vh, kb0 + ((t) + 1) * KVBLK); } SBAR();                                                   \
        qkt<BUF>(p0, p1, K_lds, r32, hi, qr);                                                                                   \
        if (CAUSAL) { if ((t) * KVBLK + KVBLK - 1 > qlo) mask_causal(p0, p1, qm - (t) * KVBLK); }                               \
        partialSM(p0, p1, m_reg, mn, al); RESC(al); finishSM(p0, p1, al, l_reg, pa0, pa1, pa2, pa3); SBAR();                    \
        pv_tile<BUF>(o, vb0, pa0, pa1, pa2, pa3); SBAR();                                                                      \
        if ((t) + 1 < NT) { VMW(); SWRITE_H(1 - BUF); }                                                                        \
        __syncthreads(); } while (0)
    TILE_STEP(0, 0); TILE_STEP(1, 1); TILE_STEP(2, 0); TILE_STEP(3, 1);
#undef RESC
#undef TILE_STEP
}
__device__ __forceinline__ void moba_past_tile(const bf16_t* Zb  , int h, int j, const unsigned* list, int cnt, int e0, bf16_t* PARTbh, float* MLbh, char* lds) {
    int tid = threadIdx.x; asm volatile("" : "+v"(tid));
    const int wid = __builtin_amdgcn_readfirstlane(tid >> 6), lane = tid & 63, r32 = lane & 31;
    const int e = e0 + wid * QBLK + r32; const bool valid = e < cnt;
    const unsigned ent = list[valid ? e : 0];
    const bf16_t* qrow = Zb + (size_t)(ent & 0xffffu) * LDZ + ZC_Q + h * 128;
    f32x16 o[4]; float m_reg, l_reg;
    moba_core<false>(qrow, Zb + ZC_KB + h * 128, Zb + ZC_VB + h * 128, j * 256, lds, tid, o, m_reg, l_reg);
    int lane_e = lane; asm volatile("" : "+v"(lane_e));
    const int r32e = lane_e & 31, hie = lane_e >> 5;
    float* ws = (float*)(lds + 2 * SHM_V + 2 * SHM_K) + wid * 64; float* li_l = ws; unsigned* en_l = (unsigned*)(ws + 32);
    if (hie == 0) { li_l[r32e] = l_reg; en_l[r32e] = valid ? ent : 0xffffffffu;
        if (valid) *(f32x2*)(MLbh + ((size_t)(ent & 0xffffu) * 3 + (ent >> 16)) * 2) = (f32x2){m_reg, l_reg}; }
    asm volatile("s_waitcnt lgkmcnt(0)" ::: "memory");
#pragma unroll
    for (int r = 0; r < 16; ++r) { const int orow = crow(r, hie); const float rl = __builtin_amdgcn_rcpf(li_l[orow]); const unsigned en = en_l[orow];
        bf16_t* dst = PARTbh + ((size_t)(en & 0xffffu) * 3 + (en >> 16)) * 128;
#pragma unroll
        for (int d0 = 0; d0 < 4; ++d0) { const float v = o[d0][r] * rl; const float vn = __shfl_xor(v, 1);
            if ((r32e & 1) == 0 && en != 0xffffffffu) *(unsigned*)(dst + d0 * 32 + r32e) = cvtpk(v, vn); } }
    asm volatile("s_waitcnt lgkmcnt(0)" ::: "memory");
    __syncthreads();
}
__device__ __forceinline__ void moba_own_unit(const bf16_t* Zb, int h, int qb, int nsel, const bf16_t* PARTbh, const float* MLbh, bf16_t* Ob  , char* lds) {
    int tid = threadIdx.x; asm volatile("" : "+v"(tid));
    const int wid = __builtin_amdgcn_readfirstlane(tid >> 6), lane = tid & 63, r32 = lane & 31;
    const int t = qb * 256 + wid * QBLK + r32;
    f32x16 o[4]; float m_reg, l_reg;
    moba_core<true>(Zb + (size_t)t * LDZ + ZC_Q + h * 128, Zb + ZC_KB + h * 128, Zb + ZC_VB + h * 128, qb * 256, lds, tid, o, m_reg, l_reg);
    int lane_e = lane; asm volatile("" : "+v"(lane_e));
    const int r32e = lane_e & 31, hie = lane_e >> 5, te = qb * 256 + wid * QBLK + r32e;
    float* ws = (float*)(lds + 2 * SHM_V + 2 * SHM_K) + wid * 64; float* f_l = ws;
    float* fl = (float*)(lds + 2 * SHM_V + 2 * SHM_K + NW * 64 * 4) + wid * 128;
    constexpr float C2 = 1.4426950408889634f * SCALE;
    float ms[3], ls[3]; float M = m_reg;
#pragma unroll
    for (int s = 0; s < 3; ++s) { ms[s] = -1e30f; ls[s] = 0.f; if (s < nsel) { const f32x2 ml = *(const f32x2*)(MLbh + ((size_t)te * 3 + s) * 2); ms[s] = ml.x; ls[s] = ml.y; M = fmaxf(M, ml.x); } }
    const float wo = l_reg * __builtin_amdgcn_exp2f((m_reg - M) * C2);
    float w[3], W = wo;
#pragma unroll
    for (int s = 0; s < 3; ++s) { w[s] = ls[s] * __builtin_amdgcn_exp2f((ms[s] - M) * C2); W += w[s]; }
    const float rW = __builtin_amdgcn_rcpf(W);
    if (hie == 0) { fl[r32e] = __builtin_amdgcn_exp2f((m_reg - M) * C2) * rW;
#pragma unroll
        for (int s = 0; s < 3; ++s) fl[(s + 1) * 32 + r32e] = w[s] * rW; }
    asm volatile("s_waitcnt lgkmcnt(0)" ::: "memory");
    (void)f_l;
#pragma unroll
    for (int r = 0; r < 16; ++r) { const float f = fl[crow(r, hie)];
#pragma unroll
        for (int d0 = 0; d0 < 4; ++d0) o[d0][r] *= f; }
    bf16_t* gl = (bf16_t*)(lds + wid * 8192);
    for (int s = 0; s < nsel; ++s) {
        { const bf16_t* src = PARTbh + ((size_t)(qb * 256 + wid * QBLK) * 3 + s) * 128; const int lane2 = lane_e;
#pragma unroll
          for (int i = 0; i < 8; ++i) { const int rr = i * 4 + (lane2 >> 4), ch = lane2 & 15; *(bf16x8*)(gl + rr * 128 + ch * 8) = ld8(src + (size_t)rr * 384 + ch * 8); } }
        asm volatile("s_waitcnt vmcnt(0) lgkmcnt(0)" ::: "memory");
#pragma unroll
        for (int r = 0; r < 16; ++r) { const int orow = crow(r, hie); const float f = fl[(s + 1) * 32 + orow];
#pragma unroll
            for (int d0 = 0; d0 < 4; ++d0) o[d0][r] += f * bf2f(gl[orow * 128 + d0 * 32 + r32e]); }
        asm volatile("s_waitcnt lgkmcnt(0)" ::: "memory");
    }
    { const bf16_t* Gw = Zb + (size_t)(qb * 256 + wid * QBLK) * LDZ + ZC_GB + h * 128; const int lane2 = lane_e;
#pragma unroll
      for (int i = 0; i < 8; ++i) { const int rr = i * 4 + (lane2 >> 4), ch = lane2 & 15; *(bf16x8*)(gl + rr * 128 + ch * 8) = ld8(Gw + (size_t)rr * LDZ + ch * 8); } }
    asm volatile("s_waitcnt vmcnt(0) lgkmcnt(0)" ::: "memory");
    bf16_t* Ow = Ob + (size_t)(qb * 256 + wid * QBLK) * LDO;
#pragma unroll
    for (int r = 0; r < 16; ++r) { const int orow = crow(r, hie);
#pragma unroll
        for (int d0 = 0; d0 < 4; ++d0) { const float v = o[d0][r] * bf2f(gl[orow * 128 + d0 * 32 + r32e]); const float vn = __shfl_xor(v, 1);
            if ((r32e & 1) == 0) *(unsigned*)(Ow + (size_t)orow * LDO + d0 * 32 + r32e) = cvtpk(v, vn); } }
    asm volatile("s_waitcnt lgkmcnt(0)" ::: "memory");
    __syncthreads();
}
#undef ROW
#undef VMW
#undef SLOAD_H
#undef SWRITE_H
}
constexpr size_t MiB = 1u << 20;
constexpr size_t WS_CTL = 0, CTL_ZERO_BYTES = 1 * MiB;
constexpr size_t WS_WINT = 2 * MiB;
constexpr size_t WS_PAT = 52 * MiB, WS_PBT = 56 * MiB, WS_WOT = 60 * MiB;
constexpr size_t WS_XN = 68 * MiB;
constexpr size_t WS_XS = 100 * MiB;
constexpr size_t WS_ROPE = 101 * MiB;
constexpr size_t WS_ZS = 102 * MiB;
constexpr size_t WS_KMP = 103 * MiB;
constexpr size_t WS_Z = 104 * MiB;
constexpr size_t WS_OA = 300 * MiB, WS_OB = 317 * MiB;
constexpr size_t WS_MRG = 334 * MiB;
constexpr size_t WS_TMP = 367 * MiB;
constexpr size_t WS_KMS = 644 * MiB;
constexpr size_t WS_CPM = 448 * MiB, WS_CQ = 464 * MiB, WS_CYQ = 496 * MiB, WS_CYL = 512 * MiB, WS_CBV = 544 * MiB, WS_CSG = 560 * MiB, WS_CSC = 576 * MiB;
constexpr size_t WS_LST = 436 * MiB;
constexpr size_t WS_PART = 592 * MiB, WS_ML = 640 * MiB;
constexpr size_t WS_END = 660 * MiB;
constexpr int CW_BAR = 4096;
constexpr int CW_CNT = 12288;
constexpr int CW_QKM = 8192;

constexpr int RING_BYTES = 131072, LDS_BYTES = 147456, LDSCTL_OFF = LDS_BYTES - 1024, MISC_OFF = LDSCTL_OFF + 320;
constexpr int NWAVES = 8, NTHR = 512;

#define XB_TMO      128
#define XB_XCNT(j)  (256  + 64 * (j))
#define XB_XSUB(j)  (1280 + 64 * (j))
#define XB_XGEN(j)  (2304 + 64 * (j))
#define XB_TOP      3328
#define XB_TOPGEN   3392
#define XCD_BAR_WORDS 3456
#define XB_SPIN_CAP (1u << 18)
__device__ __forceinline__ unsigned xb_ld(unsigned* p)              { return __hip_atomic_load(p, __ATOMIC_RELAXED, __HIP_MEMORY_SCOPE_AGENT); }
__device__ __forceinline__ unsigned xb_add(unsigned* p, unsigned v) { return __hip_atomic_fetch_add(p, v, __ATOMIC_RELAXED, __HIP_MEMORY_SCOPE_AGENT); }
__device__ __forceinline__ unsigned xb_xcc_id() { return (unsigned)__builtin_amdgcn_s_getreg((3 << 11) | 20) & 0xFu; }
#define XB_SPIN(cond, bar) do { unsigned _sp = 0; while (cond) { __builtin_amdgcn_s_sleep(1); \
    if ((++_sp & 255u) == 0u) { if (xb_ld(&(bar)[XB_TMO])) break; if (_sp > XB_SPIN_CAP) { atomicAdd(&(bar)[XB_TMO], 1u); break; } } } } while (0)
struct XcdBarrier { unsigned* bar; unsigned x; volatile LAS unsigned* st; };
__device__ __forceinline__ XcdBarrier xcd_barrier_post(unsigned* bar, volatile LAS unsigned* st) {
    XcdBarrier b; b.bar = bar; b.x = xb_xcc_id(); b.st = st;
    if (threadIdx.x == 0) (void)xb_add(&bar[XB_XCNT(b.x)], 1u);
    return b;
}
__device__ __forceinline__ void xcd_barrier_complete(unsigned* bar, unsigned x, unsigned& nloc, unsigned& nx) {
    const unsigned G = gridDim.x * gridDim.y * gridDim.z;
    unsigned sum, cnt, mine, sp = 0u;
    for (;;) {
        sum = 0u; cnt = 0u; mine = 0u;
#pragma unroll
        for (unsigned j = 0; j < 16; ++j) { const unsigned c = xb_ld(&bar[XB_XCNT(j)]); sum += c; cnt += (c > 0u) ? 1u : 0u; mine = (j == x) ? c : mine; }
        if (sum == G) break;
        __builtin_amdgcn_s_sleep(1);
        if ((++sp & 255u) == 0u) { if (xb_ld(&bar[XB_TMO])) break; if (sp > XB_SPIN_CAP) { atomicAdd(&bar[XB_TMO], 1u); break; } }
    }
    nloc = mine > 0u ? mine : 1u; nx = cnt > 0u ? cnt : 1u;
}
__device__ __forceinline__ void xcd_barrier(const XcdBarrier& b) {
    asm volatile("s_waitcnt vmcnt(0)" ::: "memory");
    __syncthreads();
    if (threadIdx.x == 0) {
        unsigned* bar = b.bar;
        __builtin_amdgcn_s_waitcnt(0);
        unsigned nloc = b.st[0], nx = b.st[1];
        if (nloc == 0u) { xcd_barrier_complete(bar, b.x, nloc, nx); b.st[0] = nloc; b.st[1] = nx; }
        const unsigned old = xb_add(&bar[XB_XSUB(b.x)], 1u);
        const unsigned gen = old / nloc;
        if (old + 1u == (gen + 1u) * nloc) {
            __builtin_amdgcn_fence(__ATOMIC_RELEASE, "agent");
            asm volatile("s_waitcnt vmcnt(0)" ::: "memory");
            const unsigned og = xb_add(&bar[XB_TOP], 1u);
            const unsigned tg = og / nx;
            if (og + 1u == (tg + 1u) * nx) xb_add(&bar[XB_TOPGEN], 1u);
            else XB_SPIN(xb_ld(&bar[XB_TOPGEN]) == tg, bar);
            __builtin_amdgcn_fence(__ATOMIC_ACQUIRE, "agent");
            xb_add(&bar[XB_XGEN(b.x)], 1u);
            asm volatile("s_waitcnt vmcnt(0)" ::: "memory");
        } else {
            XB_SPIN(xb_ld(&bar[XB_XGEN(b.x)]) == gen, bar);
            __builtin_amdgcn_fence(__ATOMIC_ACQUIRE, "agent");
            asm volatile("s_waitcnt vmcnt(0)" ::: "memory");
        }
    }
    __syncthreads();
}

struct Args { const void* in[23]; float* out; unsigned char* ws; int ph_lo, ph_hi; };
struct Frame {
    LAS unsigned char* lds; char* ldsg;
    int tid, lane, wave, G, bid;
    const float *x_p, *x_s, *st_shift, *st_wkv, *cache_k, *cache_v; const int* page_table;
    const float *ln_w, *w_in, *mu, *w0, *w2, *a0, *a2, *k_k, *k_a, *r_k, *lnx_w, *lnx_b, *p_a, *p_b, *w_o, *final_w;
    float* out; unsigned char* ws;
};

__device__ __forceinline__ void p0_transpose_item(const float* W, int K, int N, bf16_t* WT, int dst_n0, int src_n0, int k0, LAS float* scr, int lane, bool perm) {
    if (src_n0 >= 0) {
#pragma unroll 8
        for (int i = 0; i < 32; ++i) { const int kk = 2 * i + (lane >> 5); scr[kk * 33 + (lane & 31)] = W[(size_t)(k0 + kk) * N + src_n0 + (lane & 31)]; }
    } else {
#pragma unroll 8
        for (int i = 0; i < 32; ++i) { const int kk = 2 * i + (lane >> 5); scr[kk * 33 + (lane & 31)] = 0.f; }
    }
    LDS_WAIT(); asm volatile("" ::: "memory");
    const int c = lane & 7;
#pragma unroll
    for (int j = 0; j < 4; ++j) { const int n = (lane >> 3) + 8 * j; const LAS float* s = scr + (8 * c) * 33 + n;
        u32x4 o; o.x = cvt_pk_bf16(s[0 * 33], s[1 * 33]); o.y = cvt_pk_bf16(s[2 * 33], s[3 * 33]); o.z = cvt_pk_bf16(s[4 * 33], s[5 * 33]); o.w = cvt_pk_bf16(s[6 * 33], s[7 * 33]);
        *(u32x4*)(WT + (size_t)(perm ? wrow(dst_n0 + n) : dst_n0 + n) * K + k0 + 8 * c) = o; }
    LDS_WAIT(); asm volatile("" ::: "memory");
}
__device__ __forceinline__ void rms_row(const float* xrow, const float* w, bf16_t* orow, float* frow, int lane) {
    const f32x4* xr = (const f32x4*)xrow + lane; const f32x4* wr = (const f32x4*)w + lane;
    f32x4 v[8]; float s = 0.f;
#pragma unroll
    for (int j = 0; j < 8; ++j) { v[j] = xr[64 * j]; s += (v[j].x * v[j].x + v[j].y * v[j].y) + (v[j].z * v[j].z + v[j].w * v[j].w); }
    const float rstd = 1.0f / sqrtf(wave_sum(s) * (1.f / DM) + NORM_EPS);
#pragma unroll
    for (int j = 0; j < 8; ++j) { const f32x4 y = v[j] * rstd * wr[64 * j];
        u32x2 o; o.x = cvt_pk_bf16(y.x, y.y); o.y = cvt_pk_bf16(y.z, y.w);
        *((u32x2*)orow + lane + 64 * j) = o;
        if (frow) *((f32x4*)frow + lane + 64 * j) = y; }
}
__device__ __forceinline__ void phase_prologue(Frame& F) {
    LAS float* scr = (LAS float*)(F.lds + F.wave * 16384);
    const int gw = F.bid * NWAVES + F.wave, NGW = F.G * NWAVES;
    bf16_t* WinT = (bf16_t*)(F.ws + WS_WINT); bf16_t* PaT = (bf16_t*)(F.ws + WS_PAT); bf16_t* PbT = (bf16_t*)(F.ws + WS_PBT); bf16_t* WoT = (bf16_t*)(F.ws + WS_WOT);
    constexpr int I_IN = 32 * (ZLD / 32), I_P = 16 * 64, I_O = 32 * 64, NITEMS = I_IN + 2 * I_P + I_O;
    for (int it = gw; it < NITEMS; it += NGW) {
        int r = it;
        if (r < I_IN) { const int dg = r % (ZLD / 32), kb = r / (ZLD / 32); p0_transpose_item(F.w_in, DM, NIN, WinT, dg * 32, zcol_to_src(dg * 32), kb * 64, scr, F.lane, dg * 32 < ZC_WLO); continue; } r -= I_IN;
        if (r < I_P) { const int dg = r % 64, kb = r / 64; p0_transpose_item(F.p_a, DA, DM, PaT, dg * 32, dg * 32, kb * 64, scr, F.lane, true); continue; } r -= I_P;
        if (r < I_P) { const int dg = r % 64, kb = r / 64; p0_transpose_item(F.p_b, DBB, DM, PbT, dg * 32, dg * 32, kb * 64, scr, F.lane, true); continue; } r -= I_P;
        { const int dg = r % 64, kb = r / 64; p0_transpose_item(F.w_o, DM, DM, WoT, dg * 32, dg * 32, kb * 64, scr, F.lane, true); }
    }
    bf16_t* XN = (bf16_t*)(F.ws + WS_XN); bf16_t* XS = (bf16_t*)(F.ws + WS_XS);
    for (int m = gw; m < MP + 16; m += NGW) {
        if (m < MP) { const bool last = (m & (TSEQ - 1)) == TSEQ - 1; rms_row(F.x_p + (size_t)m * DM, F.ln_w, XN + (size_t)m * DM, last ? F.out + O_SHP + (size_t)(m / TSEQ) * DM : nullptr, F.lane); }
        else if (m < MP + 8) { const int b = m - MP; rms_row(F.x_s + (size_t)b * DM, F.ln_w, XS + (size_t)b * DM, F.out + O_SHS + (size_t)b * DM, F.lane); }
        else { const int b = m - MP - 8; const f32x4* sr = (const f32x4*)(F.st_shift + (size_t)b * DM) + F.lane;
#pragma unroll
            for (int j = 0; j < 8; ++j) { const f32x4 y = sr[64 * j]; u32x2 o; o.x = cvt_pk_bf16(y.x, y.y); o.y = cvt_pk_bf16(y.z, y.w); *((u32x2*)(XS + (size_t)(8 + b) * DM) + F.lane + 64 * j) = o; } }
    }
    float* rope = (float*)(F.ws + WS_ROPE);
    for (int i = F.bid * NTHR + F.tid; i < 4097 * 16; i += F.G * NTHR) {
        const int p = i >> 4, k = i & 15; const double pos = (p < 4096) ? (double)p : (double)PAST;
        const float inv = powf(500000.0f, -(float)k * (2.0f / 32.0f));
        const float ang = (float)pos * inv;
        rope[p * 32 + k] = (float)cos((double)ang); rope[p * 32 + 16 + k] = (float)sin((double)ang);
    }
    { bf16_t* OA = (bf16_t*)(F.ws + WS_OA) + (size_t)(MP + 8) * 1024; bf16_t* OB = (bf16_t*)(F.ws + WS_OB) + (size_t)(MP + 8) * 1024; bf16_t* MG = (bf16_t*)(F.ws + WS_MRG) + (size_t)(MP + 8) * DM;
      for (int i = F.bid * NTHR + F.tid; i < 8 * 1024; i += F.G * NTHR) { OA[i] = 0; OB[i] = 0; MG[i] = 0; MG[i + 8 * 1024] = 0; } }
}

template <int K>
__device__ __forceinline__ f32x4 skinny_tile(const LAS bf16_t* As, int lda, const bf16_t* WT, int n0, int lane) {
    const int r = lane & 15, q = lane >> 4;
    const bf16_t* bp = WT + (size_t)wrow_in(n0 + r) * K + q * 8;
    const LAS bf16_t* ap = As + r * lda + q * 8;
    f32x4 acc = {0.f, 0.f, 0.f, 0.f};
#pragma unroll 8
    for (int k = 0; k < K; k += 32) {
        const bf16x8 a = *(const LAS bf16x8*)(ap + k);
        const bf16x8 b = *(const bf16x8*)(bp + k);
        acc = __builtin_amdgcn_mfma_f32_16x16x32_bf16(a, b, acc, 0, 0, 0);
    }
    return acc;
}
template <int K>
__device__ __forceinline__ void stage_rows16(const bf16_t* src, LAS bf16_t* dst, int tid) {
    for (int i = tid; i < 16 * K / 8; i += NTHR) { const int r = i / (K / 8), c = i % (K / 8); *(LAS u32x4*)(dst + r * (K + 8) + c * 8) = *(const u32x4*)(src + (size_t)r * K + c * 8); }
}
__device__ __forceinline__ void phase_inproj_sample(Frame& F) {
    LAS bf16_t* As = (LAS bf16_t*)F.lds;
    stage_rows16<DM>((const bf16_t*)(F.ws + WS_XS), As, F.tid);
    LDS_WAIT(); __syncthreads();
    const bf16_t* WinT = (const bf16_t*)(F.ws + WS_WINT); float* ZS = (float*)(F.ws + WS_ZS);
    const int gw = F.bid * NWAVES + F.wave, NGW = F.G * NWAVES;
    for (int tile = gw; tile < ZLD / 16; tile += NGW) {
        const f32x4 acc = skinny_tile<DM>(As, DM + 8, WinT, tile * 16, F.lane);
        const int q = F.lane >> 4, n = tile * 16 + (F.lane & 15);
#pragma unroll
        for (int r = 0; r < 4; ++r) ZS[(size_t)(4 * q + r) * ZLD + n] = acc[r];
    }
    __syncthreads();
}

__device__ __forceinline__ void lora_unit(Frame& F, int unit) {
    LAS bf16_t* As = (LAS bf16_t*)F.lds;
    const bf16_t* src = (const bf16_t*)(F.ws + WS_XN) + (size_t)unit * 32 * DM;
    for (int i = F.tid; i < 32 * DM / 8; i += NTHR) { const int r = i >> 8, c = i & 255; *(LAS u32x4*)(As + r * (DM + 8) + c * 8) = *(const u32x4*)(src + (size_t)r * DM + c * 8); }
    LDS_WAIT(); __syncthreads();
    const int r = F.lane & 15, q = F.lane >> 4, n0 = F.wave * 16;
    const bf16_t* bp = (const bf16_t*)(F.ws + WS_WINT) + (size_t)(ZC_WLO + n0 + r) * DM + q * 8;
    const LAS bf16_t* ap = As + r * (DM + 8) + q * 8;
    f32x4 acc0 = {0.f, 0.f, 0.f, 0.f}, acc1 = acc0;
#pragma unroll 8
    for (int k = 0; k < DM; k += 32) {
        const bf16x8 bfr = *(const bf16x8*)(bp + k);
        const bf16x8 a0 = *(const LAS bf16x8*)(ap + k), a1 = *(const LAS bf16x8*)(ap + 16 * (DM + 8) + k);
        acc0 = __builtin_amdgcn_mfma_f32_16x16x32_bf16(bfr, a0, acc0, 0, 0, 0);
        acc1 = __builtin_amdgcn_mfma_f32_16x16x32_bf16(bfr, a1, acc1, 0, 0, 0);
    }
    bf16_t* Z = (bf16_t*)(F.ws + WS_Z) + ((size_t)unit * 32 + r) * ZLD + ZC_WLO + n0 + 4 * q;
    mfma_fence4(acc0); mfma_fence4(acc1);
    u32x2 w0, w1; w0.x = cvt_pk_bf16(acc0[0], acc0[1]); w0.y = cvt_pk_bf16(acc0[2], acc0[3]); w1.x = cvt_pk_bf16(acc1[0], acc1[1]); w1.y = cvt_pk_bf16(acc1[2], acc1[3]);
    *(u32x2*)Z = w0; *(u32x2*)(Z + (size_t)16 * ZLD) = w1;
    __syncthreads();
}
__device__ __forceinline__ void moba_select_unit(Frame& F, int unit) {
    const int qb = 1 + (unit >> 4), bh = unit & 15, b = bh >> 3, h = bh & 7;
    const bf16_t* Z = (const bf16_t*)(F.ws + WS_Z); const float* kmp = (const float*)(F.ws + WS_KMP);
    LAS float* km = (LAS float*)(F.lds + att::ATT_LDS);
    LAS unsigned* sel = (LAS unsigned*)(F.lds + att::ATT_LDS + 16 * 132 * 4);
    for (int idx = F.tid; idx < qb * 128; idx += NTHR) { const int n = idx >> 7, d = idx & 127; const int pm = b * 16 + n, col = h * 128 + d;
        km[n * 132 + d] = (kmp[(size_t)(pm * 2 + 0) * 1024 + col] + kmp[(size_t)(pm * 2 + 1) * 1024 + col]) * (1.0f / 256.0f); }
    LDS_WAIT(); __syncthreads();
    {
        int tid_g = F.tid; asm volatile("" : "+v"(tid_g));
        const int row = tid_g >> 1, part = tid_g & 1;
        const bf16_t* qp = Z + (size_t)(b * TSEQ + qb * 256 + row) * ZLD + ZC_Q + h * 128 + part * 64;
        float q[64];
#pragma unroll
        for (int c8 = 0; c8 < 8; ++c8) { float t8[8]; ld8bf(qp + c8 * 8, t8);
#pragma unroll
            for (int e = 0; e < 8; ++e) q[c8 * 8 + e] = t8[e]; }
        float g[15];
#pragma unroll
        for (int n = 0; n < 15; ++n) { float s = 0.f;
            if (n < qb) {
#pragma unroll
                for (int d4 = 0; d4 < 16; ++d4) { const f32x4 kv = *(const LAS f32x4*)(km + n * 132 + part * 64 + d4 * 4);
                    s += (q[d4 * 4] * kv.x + q[d4 * 4 + 1] * kv.y) + (q[d4 * 4 + 2] * kv.z + q[d4 * 4 + 3] * kv.w); }
            }
            s += __shfl_xor(s, 1); g[n] = s; }
        unsigned mask = 0u;
#pragma unroll
        for (int pass = 0; pass < 3; ++pass) { float best = -__builtin_inff(); int bi = -1;
#pragma unroll
            for (int n = 0; n < 15; ++n) { const bool ok = (n < qb) && !((mask >> n) & 1u) && (g[n] > best); best = ok ? g[n] : best; bi = ok ? n : bi; }
            if (bi >= 0) mask |= 1u << bi; }
        if (part == 0) sel[row] = mask;
    }
    LDS_WAIT(); __syncthreads();
    unsigned* CNT = (unsigned*)(F.ws + WS_CTL) + CW_CNT; unsigned* LST = (unsigned*)(F.ws + WS_LST);
    for (int j = F.wave; j < qb; j += NWAVES) {
        unsigned mk[4]; int c = 0;
#pragma unroll
        for (int k = 0; k < 4; ++k) { mk[k] = sel[4 * F.lane + k]; c += (int)((mk[k] >> j) & 1u); }
        int incl = c;
#pragma unroll
        for (int off = 1; off < 64; off <<= 1) { const int up = __shfl_up(incl, off); incl += (F.lane >= off) ? up : 0; }
        const int total = __shfl(incl, 63);
        unsigned base = 0u; if (F.lane == 0) base = __hip_atomic_fetch_add(CNT + bh * 15 + j, (unsigned)total, __ATOMIC_RELAXED, __HIP_MEMORY_SCOPE_AGENT);
        base = (unsigned)__shfl((int)base, 0);
        unsigned off = base + (unsigned)(incl - c); unsigned* lst = LST + (size_t)(bh * 15 + j) * 4096;
#pragma unroll
        for (int k = 0; k < 4; ++k) if ((mk[k] >> j) & 1u) { lst[off++] = (unsigned)(qb * 256 + 4 * F.lane + k) | ((unsigned)__popc(mk[k] & ((1u << j) - 1u)) << 16); }
    }
    __syncthreads();
}
__device__ __forceinline__ void moba_past_phase(Frame& F, int nwork) {
    LAS int* toff = (LAS int*)(F.lds + 100000);
    const unsigned* CNT = (const unsigned*)(F.ws + WS_CTL) + CW_CNT;
    if (F.tid < 240) toff[F.tid + 1] = (int)((CNT[F.tid] + 255u) >> 8);
    LDS_WAIT(); __syncthreads();
    if (F.tid == 0) { int acc = 0; toff[0] = 0; for (int i = 1; i <= 240; ++i) { acc += toff[i]; toff[i] = acc; } }
    LDS_WAIT(); __syncthreads();
    const int T = toff[240];
    for (int g = F.bid < nwork ? F.bid : T; g < T; g += nwork) {
        int lo = 0, hi = 239;
        while (lo < hi) { const int mid = (lo + hi + 1) >> 1; if (toff[mid] <= g) lo = mid; else hi = mid - 1; }
        const int i = lo, bh = i / 15, j = i - bh * 15, tile = g - toff[i], b = bh >> 3, h = bh & 7;
        att::moba_past_tile((const bf16_t*)(F.ws + WS_Z) + (size_t)b * TSEQ * ZLD, h, j, (const unsigned*)(F.ws + WS_LST) + (size_t)i * 4096, (int)CNT[i], tile * 256,
                            (bf16_t*)(F.ws + WS_PART) + (size_t)bh * TSEQ * 384, (float*)(F.ws + WS_ML) + (size_t)bh * TSEQ * 6, F.ldsg);
    }
}
__device__ __forceinline__ void moba_own(Frame& F, int unit) {
    const int qb = unit >> 4, bh = unit & 15, b = bh >> 3, h = bh & 7;
    att::moba_own_unit((const bf16_t*)(F.ws + WS_Z) + (size_t)b * TSEQ * ZLD, h, qb, qb < 3 ? qb : 3, (const bf16_t*)(F.ws + WS_PART) + (size_t)bh * TSEQ * 384, (const float*)(F.ws + WS_ML) + (size_t)bh * TSEQ * 6,
                       (bf16_t*)(F.ws + WS_OB) + (size_t)b * TSEQ * 1024 + h * 128, F.ldsg);
}

__device__ __forceinline__ void sample_kmean_page(Frame& F, int unit) {
    const int b = unit >> 7, pg = unit & 127, cq = F.tid & 255, rg = F.tid >> 8;
    const int page = F.page_table[b * NPG + pg];
    const f32x4* src = (const f32x4*)(F.cache_k + (size_t)page * PAGE * 1024) + cq;
    f32x4 acc = {0.f, 0.f, 0.f, 0.f};
#pragma unroll 16
    for (int r = rg; r < PAGE; r += 2) acc += __builtin_nontemporal_load(src + (size_t)r * 256);
    LAS f32x4* red = (LAS f32x4*)F.lds;
    if (rg == 1) red[cq] = acc;
    LDS_WAIT(); __syncthreads();
    if (rg == 0) { acc += red[cq]; *((f32x4*)((float*)(F.ws + WS_KMS) + (size_t)unit * 1024) + cq) = acc; }
    __syncthreads();
}
__device__ __forceinline__ int queue_pop(Frame& F, unsigned* ctr) {
    volatile LAS int* tk = (volatile LAS int*)(F.lds + LDSCTL_OFF + 64);
    __syncthreads();
    if (F.tid == 0) *tk = (int)__hip_atomic_fetch_add(ctr, 1u, __ATOMIC_RELAXED, __HIP_MEMORY_SCOPE_AGENT);
    __syncthreads();
    return *tk;
}
__device__ __forceinline__ void sample_attn_unit(Frame& F, int unit) {
    const int b = unit >> 3, h = unit & 7;
    const float* ZS = (const float*)(F.ws + WS_ZS) + (size_t)b * ZLD; const float* rope = (const float*)(F.ws + WS_ROPE) + 4096 * 32;
    LAS float* q = (LAS float*)F.lds; LAS float* kn = q + 128; LAS float* sc = kn + 128; LAS float* redm = sc + 800; LAS int* selb = (LAS int*)(redm + 16); LAS float* oacc = redm + 32;
    if (F.tid < 256) {
        const int d = F.tid & 127, isk = F.tid >> 7; const float* src = ZS + (isk ? ZC_KB : ZC_Q) + h * 128;
        float v = src[d];
        if (d < 32) { const int i = d & 15; const float c = rope[i], s = rope[16 + i]; const float x1 = src[i], x2 = src[16 + i]; v = (d < 16) ? (x1 * c - x2 * s) : (x2 * c + x1 * s); }
        (isk ? kn : q)[d] = v;
        if (isk) { F.out[O_KS + (size_t)b * 1024 + h * 128 + d] = v; F.out[O_VS + (size_t)b * 1024 + h * 128 + d] = ZS[ZC_VB + h * 128 + d]; }
    }
    LDS_WAIT(); __syncthreads();
    if (F.wave == 0) {
        const float* km = (const float*)(F.ws + WS_KMS) + ((size_t)b * 128 + 2 * F.lane) * 4 * 1024 + h * 128; float g = 0.f;
        for (int d = 0; d < 128; d += 4) { f32x4 kv = *(const f32x4*)(km + d);
#pragma unroll
            for (int p = 1; p < 8; ++p) kv += *(const f32x4*)(km + (size_t)p * 1024 + d);
            kv = kv * (1.0f / 256.0f); g += (q[d] * kv.x + q[d + 1] * kv.y) + (q[d + 2] * kv.z + q[d + 3] * kv.w); }
        for (int pass = 0; pass < 3; ++pass) { const float mx = wave_max(g); const unsigned long long bal = __ballot(g == mx); const int bi = __ffsll((long long)bal) - 1;
            if (F.lane == 0) selb[pass] = bi; if (F.lane == bi) g = -__builtin_inff(); }
    }
    LDS_WAIT(); __syncthreads();
    LAS int* pgs = selb + 4;
    if (F.tid < 6) pgs[F.tid] = F.page_table[b * NPG + 2 * selb[F.tid >> 1] + (F.tid & 1)];
    LDS_WAIT(); __syncthreads();
    float smax = -__builtin_inff();
    { const int sub = F.lane & 7, kq = F.lane >> 3; float qv[16];
#pragma unroll
      for (int e = 0; e < 16; ++e) qv[e] = q[sub * 16 + e];
      for (int p0 = 0; p0 < 12; p0 += 4) {
          f32x4 kv[4][4];
#pragma unroll
          for (int pp = 0; pp < 4; ++pp) { const int kidx = ((p0 + pp) * 8 + F.wave) * 8 + kq; const float* kr = F.cache_k + ((size_t)pgs[kidx >> 7] * PAGE + (kidx & 127)) * 1024 + h * 128 + sub * 16;
#pragma unroll
              for (int e = 0; e < 4; ++e) kv[pp][e] = *(const f32x4*)(kr + 4 * e); }
#pragma unroll
          for (int pp = 0; pp < 4; ++pp) { const int kidx = ((p0 + pp) * 8 + F.wave) * 8 + kq; float s = 0.f;
#pragma unroll
              for (int e = 0; e < 4; ++e) s += (qv[4 * e] * kv[pp][e].x + qv[4 * e + 1] * kv[pp][e].y) + (qv[4 * e + 2] * kv[pp][e].z + qv[4 * e + 3] * kv[pp][e].w);
              s += __shfl_xor(s, 1); s += __shfl_xor(s, 2); s += __shfl_xor(s, 4);
              s *= att::SCALE; if (sub == 0) sc[kidx] = s; smax = fmaxf(smax, s); } }
      if (F.tid == 0) { float s = 0.f; for (int d = 0; d < 128; ++d) s += q[d] * kn[d]; s *= att::SCALE; sc[768] = s; smax = fmaxf(smax, s); } }
    smax = wave_max(smax); if (F.lane == 0) redm[F.wave] = smax;
    LDS_WAIT(); __syncthreads();
    float mx = redm[0];
#pragma unroll
    for (int w = 1; w < 8; ++w) mx = fmaxf(mx, redm[w]);
    __syncthreads();
    float psum = 0.f;
    for (int kidx = F.tid; kidx < 769; kidx += NTHR) { const float p = __expf(sc[kidx] - mx); sc[kidx] = p; psum += p; }
    psum = wave_sum(psum); if (F.lane == 0) redm[8 + F.wave] = psum;
    LDS_WAIT(); __syncthreads();
    float tot = 0.f;
#pragma unroll
    for (int w = 0; w < 8; ++w) tot += redm[8 + w];
    {
        const int d4 = F.tid & 31, kg = F.tid >> 5; f32x4 a = {0.f, 0.f, 0.f, 0.f};
        for (int k0 = 0; k0 < 48; k0 += 16) {
            f32x4 vv[16];
#pragma unroll
            for (int e = 0; e < 16; ++e) { const int kidx = kg * 48 + k0 + e; vv[e] = *(const f32x4*)(F.cache_v + ((size_t)pgs[kidx >> 7] * PAGE + (kidx & 127)) * 1024 + h * 128 + d4 * 4); }
#pragma unroll
            for (int e = 0; e < 16; ++e) a += vv[e] * sc[kg * 48 + k0 + e];
        }
        *(LAS f32x4*)(oacc + kg * 128 + d4 * 4) = a;
    }
    LDS_WAIT(); __syncthreads();
    if (F.tid < 128) { const int d = F.tid; float a = sc[768] * ZS[ZC_VB + h * 128 + d];
#pragma unroll
        for (int g16 = 0; g16 < 16; ++g16) a += oacc[g16 * 128 + d];
        a = a / tot * siluf_(ZS[ZC_GB + h * 128 + d]);
        ((bf16_t*)(F.ws + WS_OB))[(size_t)(MP + b) * 1024 + h * 128 + d] = (bf16_t)(cvt_pk_bf16(a, a) & 0xffffu); }
    __syncthreads();
}
__device__ __forceinline__ void sample_wkv_unit(Frame& F, int unit, LAS float* scr  ) {
    const int b = unit >> 4, h = unit & 15, j = F.lane, hc = h * 64 + j;
    const float* zc = (const float*)(F.ws + WS_ZS) + (size_t)b * ZLD; const float* zp = (const float*)(F.ws + WS_ZS) + (size_t)(8 + b) * ZLD;
#define LERP1(zcol, muoff) (zc[zcol] + (zp[zcol] - zc[zcol]) * F.mu[muoff])
    const float r = LERP1(ZC_R + hc, hc), k = LERP1(ZC_K + hc, 1088 + hc), v = LERP1(ZC_V + hc, 2112 + hc), g = LERP1(ZC_G + hc, 3200 + hc);
    const float twl = tanhf(LERP1(ZC_WLO + j, 1024 + j)), alo = LERP1(ZC_ALO + j, 3136 + j);
#undef LERP1
    float wl = F.w0[hc], aa = F.a0[hc];
    for (int m = 0; m < 64; ++m) { wl += __shfl(twl, m) * F.w2[(size_t)m * DA + hc]; aa += __shfl(alo, m) * F.a2[(size_t)m * DA + hc]; }
    const float dec = __expf(-0.6065306597126334f * sigmoidf_(wl)), a = sigmoidf_(aa);
    float kk = k * F.k_k[hc]; const float nrm = fmaxf(sqrtf(wave_sum(kk * kk)), 1e-12f); kk = kk / nrm;
    const float kt = k * (1.0f + (a - 1.0f) * F.k_a[hc]), bb = kk * a;
    const float bon = wave_sum(r * kt * F.r_k[hc]);
    scr[j] = dec; scr[64 + j] = kk; scr[128 + j] = bb; scr[192 + j] = kt; scr[256 + j] = r;
    LDS_WAIT(); asm volatile("" ::: "memory");
    const float* Sg = F.st_wkv + ((size_t)(b * 16 + h) * 64 + j) * 64; float* So = F.out + O_WKS + ((size_t)(b * 16 + h) * 64 + j) * 64;
    float S[64];
#pragma unroll
    for (int c4 = 0; c4 < 16; ++c4) { const f32x4 t = *(const f32x4*)(Sg + c4 * 4); S[c4 * 4] = t.x; S[c4 * 4 + 1] = t.y; S[c4 * 4 + 2] = t.z; S[c4 * 4 + 3] = t.w; }
    float sa = 0.f;
#pragma unroll
    for (int c = 0; c < 64; ++c) sa -= S[c] * scr[64 + c];
    float y = 0.f;
#pragma unroll
    for (int c = 0; c < 64; ++c) { S[c] = S[c] * scr[c] + sa * scr[128 + c] + v * scr[192 + c]; y += S[c] * scr[256 + c]; }
#pragma unroll
    for (int c4 = 0; c4 < 16; ++c4) *(f32x4*)(So + c4 * 4) = (f32x4){S[c4 * 4], S[c4 * 4 + 1], S[c4 * 4 + 2], S[c4 * 4 + 3]};
    const float mean = wave_sum(y) * (1.f / 64.f), d = y - mean, var = wave_sum(d * d) * (1.f / 64.f);
    const float yn = d * (1.0f / sqrtf(var + GN_EPS)) * F.lnx_w[hc] + F.lnx_b[hc];
    const float ov = (yn + bon * v) * siluf_(g);
    ((bf16_t*)(F.ws + WS_OA))[(size_t)(MP + b) * 1024 + hc] = (bf16_t)(cvt_pk_bf16(ov, ov) & 0xffffu);
    LDS_WAIT(); asm volatile("" ::: "memory");
}

__device__ __forceinline__ void phase_merge_sample(Frame& F) {
    LAS bf16_t* As = (LAS bf16_t*)F.lds; LAS bf16_t* Bs = As + 16 * (DA + 8);
    stage_rows16<DA>((const bf16_t*)(F.ws + WS_OA) + (size_t)MP * 1024, As, F.tid); stage_rows16<DBB>((const bf16_t*)(F.ws + WS_OB) + (size_t)MP * 1024, Bs, F.tid);
    LDS_WAIT(); __syncthreads();
    const float* ZS = (const float*)(F.ws + WS_ZS); bf16_t* MG = (bf16_t*)(F.ws + WS_MRG) + (size_t)MP * DM;
    const int gw = F.bid * NWAVES + F.wave, NGW = F.G * NWAVES;
    for (int tile = gw; tile < DM / 16; tile += NGW) {
        const f32x4 a = skinny_tile<DA>(As, DA + 8, (const bf16_t*)(F.ws + WS_PAT), tile * 16, F.lane);
        const f32x4 c = skinny_tile<DBB>(Bs, DBB + 8, (const bf16_t*)(F.ws + WS_PBT), tile * 16, F.lane);
        const int q = F.lane >> 4, n = tile * 16 + (F.lane & 15);
        if (q < 2) {
#pragma unroll
            for (int r = 0; r < 4; ++r) { const int m = 4 * q + r; const float ga = sigmoidf_(ZS[(size_t)m * ZLD + ZC_GATE + n]), gb = sigmoidf_(ZS[(size_t)m * ZLD + ZC_GATE + DM + n]);
                const float v = ga * a[r] + gb * c[r]; MG[(size_t)m * DM + n] = (bf16_t)(cvt_pk_bf16(v, v) & 0xffffu); } }
    }
    __syncthreads();
}
__device__ __forceinline__ void phase_out_sample(Frame& F) {
    LAS bf16_t* As = (LAS bf16_t*)F.lds;
    stage_rows16<DM>((const bf16_t*)(F.ws + WS_MRG) + (size_t)MP * DM, As, F.tid);
    LDS_WAIT(); __syncthreads();
    const int gw = F.bid * NWAVES + F.wave, NGW = F.G * NWAVES;
    for (int tile = gw; tile < DM / 16; tile += NGW) {
        const f32x4 a = skinny_tile<DM>(As, DM + 8, (const bf16_t*)(F.ws + WS_WOT), tile * 16, F.lane);
        const int q = F.lane >> 4, n = tile * 16 + (F.lane & 15);
        if (q < 2) {
#pragma unroll
            for (int r = 0; r < 4; ++r) { const int m = 4 * q + r; F.out[O_YS + (size_t)m * DM + n] = F.x_s[(size_t)m * DM + n] + a[r]; } }
    }
    __syncthreads();
}
__device__ __forceinline__ void final_norm_row(Frame& F, float* rowp) {
    f32x4* xr = (f32x4*)rowp + F.lane; const f32x4* wr = (const f32x4*)F.final_w + F.lane;
    f32x4 v[8]; float s = 0.f;
#pragma unroll
    for (int j = 0; j < 8; ++j) { v[j] = xr[64 * j]; s += (v[j].x * v[j].x + v[j].y * v[j].y) + (v[j].z * v[j].z + v[j].w * v[j].w); }
    const float rstd = 1.0f / sqrtf(wave_sum(s) * (1.f / DM) + NORM_EPS);
#pragma unroll
    for (int j = 0; j < 8; ++j) xr[64 * j] = v[j] * rstd * wr[64 * j];
}
namespace wkv {
constexpr int PITCH = 72, SLOT = 64 * PITCH * 2;
constexpr int S_KQ = 0, S_RQ = 1, S_V = 2, S_BBAR = 3, S_KBAR = 4, S_BK = 5, S_KK = 6, S_M = 7, S_N = 8, S_AY = 9, S_BY = 10, S_X0 = 11, S_NV = 12, S_W2 = 13, S_A2 = 14;
constexpr int OFF_RED = 15 * SLOT;
constexpr size_t UNIT_E = 64 * 64;
__device__ __forceinline__ LAS bf16_t* slot(LAS unsigned char* lds, int s) { return (LAS bf16_t*)(lds + s * SLOT); }
__device__ __forceinline__ void frag_row(const LAS bf16_t* img, int r0, int lane, bf16x8 (&f)[2]) {
    const LAS bf16_t* p = img + (r0 + (lane & 15)) * PITCH + 8 * (lane >> 4);
    f[0] = *(const LAS bf16x8*)p; f[1] = *(const LAS bf16x8*)(p + 32);
}
__device__ __forceinline__ void frag_tr(const LAS bf16_t* img, int n0, int lane, bf16x8 (&f)[2]) {
    const int q = lane >> 4, idx = lane & 15;
    const unsigned a = (unsigned)(uintptr_t)(img + (8 * q + (idx >> 2)) * PITCH + n0 + 4 * (idx & 3));
    s16x4 x0, x1, x2, x3;
    asm volatile("ds_read_b64_tr_b16 %0, %1" : "=&v"(x0) : "v"(a) : "memory");
    asm volatile("ds_read_b64_tr_b16 %0, %1 offset:%2" : "=&v"(x1) : "v"(a), "i"(4 * PITCH * 2) : "memory");
    asm volatile("ds_read_b64_tr_b16 %0, %1 offset:%2" : "=&v"(x2) : "v"(a), "i"(32 * PITCH * 2) : "memory");
    asm volatile("ds_read_b64_tr_b16 %0, %1 offset:%2" : "=&v"(x3) : "v"(a), "i"(36 * PITCH * 2) : "memory");
    asm volatile("s_waitcnt lgkmcnt(0)" : "+v"(x0), "+v"(x1), "+v"(x2), "+v"(x3) :: "memory");
    f[0] = (bf16x8){x0[0], x0[1], x0[2], x0[3], x1[0], x1[1], x1[2], x1[3]};
    f[1] = (bf16x8){x2[0], x2[1], x2[2], x2[3], x3[0], x3[1], x3[2], x3[3]};
}
template <bool SWAP> __device__ __forceinline__ void mma(const bf16x8 (&a)[2], const bf16x8 (&b)[2], f32x4& acc) {
#pragma unroll
    for (int ks = 0; ks < 2; ++ks) acc = SWAP ? __builtin_amdgcn_mfma_f32_16x16x32_bf16(b[ks], a[ks], acc, 0, 0, 0) : __builtin_amdgcn_mfma_f32_16x16x32_bf16(a[ks], b[ks], acc, 0, 0, 0);
}
__device__ __forceinline__ void mfma_fence(f32x4& v) { asm volatile("s_nop 7\n\ts_nop 7" : "+v"(v)); }
__device__ __forceinline__ u32x2 pack4(f32x4 v) { u32x2 w; w.x = cvt_pk_bf16(v[0], v[1]); w.y = cvt_pk_bf16(v[2], v[3]); return w; }
__device__ __forceinline__ f32x4 unpack4(u32x2 w) { return (f32x4){bflo(w.x), bfhi(w.x), bflo(w.y), bfhi(w.y)}; }
__device__ __forceinline__ void st_img(LAS bf16_t* img, int m0, int n0, int lane, f32x4 v) { mfma_fence(v); *(LAS u32x2*)(img + (m0 + (lane & 15)) * PITCH + n0 + 4 * (lane >> 4)) = pack4(v); }
__device__ __forceinline__ f32x4 ld_img(const LAS bf16_t* img, int m0, int n0, int lane) { return unpack4(*(const LAS u32x2*)(img + (m0 + (lane & 15)) * PITCH + n0 + 4 * (lane >> 4))); }
#define WKV_BAR() do { asm volatile("s_waitcnt lgkmcnt(0)" ::: "memory"); __builtin_amdgcn_s_barrier(); asm volatile("" ::: "memory"); } while (0)

struct TrRaw { s16x4 x0, x1, x2, x3; };
__device__ __forceinline__ void tr_issue(const LAS bf16_t* img, int n0, int lane, TrRaw& t) {
    const int q = lane >> 4, idx = lane & 15;
    const unsigned a = (unsigned)(uintptr_t)(img + (8 * q + (idx >> 2)) * PITCH + n0 + 4 * (idx & 3));
    asm volatile("ds_read_b64_tr_b16 %0, %1" : "=&v"(t.x0) : "v"(a) : "memory");
    asm volatile("ds_read_b64_tr_b16 %0, %1 offset:%2" : "=&v"(t.x1) : "v"(a), "i"(4 * PITCH * 2) : "memory");
    asm volatile("ds_read_b64_tr_b16 %0, %1 offset:%2" : "=&v"(t.x2) : "v"(a), "i"(32 * PITCH * 2) : "memory");
    asm volatile("ds_read_b64_tr_b16 %0, %1 offset:%2" : "=&v"(t.x3) : "v"(a), "i"(36 * PITCH * 2) : "memory");
}
#define TRV(t) "+v"(t.x0), "+v"(t.x1), "+v"(t.x2), "+v"(t.x3)
#define TR_WAIT2(a, b) asm volatile("s_waitcnt lgkmcnt(0)" : TRV(a), TRV(b) :: "memory")
#define TR_WAIT4(a, b, c, d) asm volatile("s_waitcnt lgkmcnt(0)" : TRV(a), TRV(b), TRV(c), TRV(d) :: "memory")
#define TR_WAIT6(a, b, c, d, e, f) asm volatile("s_waitcnt lgkmcnt(0)" : TRV(a), TRV(b), TRV(c), TRV(d), TRV(e), TRV(f) :: "memory")
#define TR_WAIT7(a, b, c, d, e, f, g) asm volatile("s_waitcnt lgkmcnt(0)" : TRV(a), TRV(b), TRV(c), TRV(d), TRV(e), TRV(f), TRV(g) :: "memory")
__device__ __forceinline__ void tr_frag(const TrRaw& t, bf16x8 (&f)[2]) {
    f[0] = (bf16x8){t.x0[0], t.x0[1], t.x0[2], t.x0[3], t.x1[0], t.x1[1], t.x1[2], t.x1[3]};
    f[1] = (bf16x8){t.x2[0], t.x2[1], t.x2[2], t.x2[3], t.x3[0], t.x3[1], t.x3[2], t.x3[3]};
}
constexpr int OFF_CST = OFF_RED + 4352;
constexpr int STP = 392;
__device__ __forceinline__ void st_fetch(const bf16_t* Z, int b, int h, int c, int tid, u32x4 (&pf)[7]) {
    const bf16_t* zb = Z + ((size_t)b * TSEQ + (size_t)c * 64) * ZLD;
#pragma unroll
    for (int i = 0; i < 7; ++i) { const int idx = tid + NTHR * i; pf[i] = (u32x4){0u, 0u, 0u, 0u};
        if (idx < 65 * 48) { const int rw = idx / 48, rem = idx - rw * 48, reg = rem >> 3, ch = rem & 7;
            const int col = (reg < 4) ? (reg * 1024 + h * 64) : (reg == 4 ? ZC_WLO : ZC_ALO);
            if (rw > 0 || c > 0) pf[i] = *(const u32x4*)(zb + ((ptrdiff_t)rw - 1) * ZLD + col + ch * 8); } }
}
__device__ __forceinline__ void scanA_unit(Frame& F, int bh, int c, bool load_w, u32x4 (&pf)[7], int nbh, int nc, bool has_next, const float* kmsrc, float* kmdst) {
    int tid = F.tid; asm volatile("" : "+v"(tid));
    const int lane = tid & 63, wv = F.wave, tt = lane, cg = wv;
    const int b = bh >> 4, h = bh & 15;
    const size_t uid = (size_t)bh * 64 + c;
    LAS unsigned char* L = F.lds;
    LAS float* red = (LAS float*)(L + OFF_RED); LAS float* red2 = red + 512; LAS float* gC = red2 + 512; LAS float* cst = (LAS float*)(L + OFF_CST);
    LAS float* WLf = (LAS float*)(L + S_X0 * SLOT); LAS float* AAf = (LAS float*)(L + S_M * SLOT);
    const bf16_t* Z = (const bf16_t*)(F.ws + WS_Z);
    if (load_w) {
        const int m = tid >> 3, j = (tid & 7) * 8; float t8[8];
        ld8f(F.w2 + (size_t)m * DA + h * 64 + j, t8); *(LAS u32x4*)(slot(L, S_W2) + m * PITCH + j) = (u32x4){cvt_pk_bf16(t8[0], t8[1]), cvt_pk_bf16(t8[2], t8[3]), cvt_pk_bf16(t8[4], t8[5]), cvt_pk_bf16(t8[6], t8[7])};
        ld8f(F.a2 + (size_t)m * DA + h * 64 + j, t8); *(LAS u32x4*)(slot(L, S_A2) + m * PITCH + j) = (u32x4){cvt_pk_bf16(t8[0], t8[1]), cvt_pk_bf16(t8[2], t8[3]), cvt_pk_bf16(t8[4], t8[5]), cvt_pk_bf16(t8[6], t8[7])};
#pragma unroll
        for (int i = 0; i < 2; ++i) { const int idx = tid + NTHR * i;
            if (idx < 11 * 64) { const int k = idx >> 6, jj = idx & 63, hj = h * 64 + jj; float v;
                switch (k) { case 0: v = F.mu[hj]; break; case 1: v = F.mu[1088 + hj]; break; case 2: v = F.mu[2112 + hj]; break; case 3: v = F.mu[3200 + hj]; break;
                             case 4: v = F.mu[1024 + jj]; break; case 5: v = F.mu[3136 + jj]; break; case 6: v = F.w0[hj]; break; case 7: v = F.a0[hj]; break;
                             case 8: v = F.k_k[hj]; break; case 9: v = F.k_a[hj]; break; default: v = F.r_k[hj]; break; }
                cst[idx] = v; } }
    }
    LAS bf16_t* ST = (LAS bf16_t*)L;
#pragma unroll
    for (int i = 0; i < 7; ++i) { const int idx = tid + NTHR * i;
        if (idx < 65 * 48) { const int rw = idx / 48, rem = idx - rw * 48, reg = rem >> 3, ch = rem & 7; *(LAS u32x4*)(ST + rw * STP + reg * 64 + ch * 8) = pf[i]; } }
    f32x4 kst[8], kacc = {0.f, 0.f, 0.f, 0.f};
#define KM_ISSUE(bt) do { _Pragma("unroll") for (int i = 0; i < 8; ++i) kst[i] = __builtin_nontemporal_load((const f32x4*)(kmsrc + (size_t)(16 * (bt) + 2 * i) * 1024)); } while (0)
#define KM_SUM() do { _Pragma("unroll") for (int i = 0; i < 8; ++i) kacc += kst[i]; } while (0)
    KM_ISSUE(0);
    WKV_BAR();
    float r8[8], k8[8], v8[8], g8[8];
#define LERP8(dst, reg_) do { float cur_[8], prv_[8], mu_[8]; ld8bf_lds(ST + (tt + 1) * STP + (reg_) * 64 + cg * 8, cur_); ld8bf_lds(ST + tt * STP + (reg_) * 64 + cg * 8, prv_); ld8f_lds(cst + (reg_) * 64 + cg * 8, mu_); \
        _Pragma("unroll") for (int e = 0; e < 8; ++e) dst[e] = cur_[e] + (prv_[e] - cur_[e]) * mu_[e]; } while (0)
    LERP8(r8, 0); LERP8(k8, 1); LERP8(v8, 2); LERP8(g8, 3);
    float wl8[8], al8[8]; LERP8(wl8, 4); LERP8(al8, 5);
#undef LERP8
#pragma unroll
    for (int e = 0; e < 8; ++e) wl8[e] = 1.0f - 2.0f * __builtin_amdgcn_rcpf(1.0f + __builtin_amdgcn_exp2f(2.8853900817779268f * wl8[e]));
    *(LAS u32x4*)(slot(L, S_AY) + tt * PITCH + cg * 8) = (u32x4){cvt_pk_bf16(wl8[0], wl8[1]), cvt_pk_bf16(wl8[2], wl8[3]), cvt_pk_bf16(wl8[4], wl8[5]), cvt_pk_bf16(wl8[6], wl8[7])};
    *(LAS u32x4*)(slot(L, S_BY) + tt * PITCH + cg * 8) = (u32x4){cvt_pk_bf16(al8[0], al8[1]), cvt_pk_bf16(al8[2], al8[3]), cvt_pk_bf16(al8[4], al8[5]), cvt_pk_bf16(al8[6], al8[7])};
    float kk[8];
    { float kkc[8]; ld8f_lds(cst + 8 * 64 + cg * 8, kkc); float ss = 0.f;
#pragma unroll
      for (int e = 0; e < 8; ++e) { kk[e] = k8[e] * kkc[e]; ss += kk[e] * kk[e]; }
      red[tt * 8 + cg] = ss; }
    WKV_BAR();
    const int mt = wv & 3, ntp = wv >> 2, m0 = mt * 16, n0 = ntp * 32;
    { bf16x8 a[2], a2[2], b0[2], b1[2]; TrRaw t0, t1, t2, t3;
      frag_row(slot(L, S_AY), m0, lane, a); frag_row(slot(L, S_BY), m0, lane, a2);
      tr_issue(slot(L, S_W2), n0, lane, t0); tr_issue(slot(L, S_W2), n0 + 16, lane, t1); tr_issue(slot(L, S_A2), n0, lane, t2); tr_issue(slot(L, S_A2), n0 + 16, lane, t3);
      TR_WAIT4(t0, t1, t2, t3);
      f32x4 c0 = {0.f, 0.f, 0.f, 0.f}, c1 = c0, d0 = c0, d1 = c0;
      tr_frag(t0, b0); tr_frag(t1, b1); mma<true>(a, b0, c0); mma<true>(a, b1, c1);
      tr_frag(t2, b0); tr_frag(t3, b1); mma<true>(a2, b0, d0); mma<true>(a2, b1, d1);
      const int rr = m0 + (lane & 15), cc = n0 + 4 * (lane >> 4);
      *(LAS f32x4*)(WLf + rr * 68 + cc) = c0; *(LAS f32x4*)(WLf + rr * 68 + cc + 16) = c1;
      *(LAS f32x4*)(AAf + rr * 68 + cc) = d0; *(LAS f32x4*)(AAf + rr * 68 + cc + 16) = d1; }
    WKV_BAR();
    KM_SUM();
    float bon_part;
    { float wl[8], aa[8], t8[8];
      ld8f_lds(cst + 6 * 64 + cg * 8, t8);
#pragma unroll
      for (int e = 0; e < 8; ++e) wl[e] = t8[e] + WLf[tt * 68 + cg * 8 + e];
      ld8f_lds(cst + 7 * 64 + cg * 8, t8);
#pragma unroll
      for (int e = 0; e < 8; ++e) aa[e] = t8[e] + AAf[tt * 68 + cg * 8 + e];
      float tot = 0.f;
#pragma unroll
      for (int e = 0; e < 8; ++e) tot += red[tt * 8 + e];
      const float inv = 1.0f / fmaxf(sqrtf(tot), 1e-12f);
      float kac[8], rkc[8]; ld8f_lds(cst + 9 * 64 + cg * 8, kac); ld8f_lds(cst + 10 * 64 + cg * 8, rkc);
      float ew[8], cum[8], av[8], kt[8], bb[8];
      bon_part = 0.f;
#pragma unroll
      for (int e = 0; e < 8; ++e) { ew[e] = 0.6065306597126334f * sigmoidf_(wl[e]); cum[e] = ew[e]; av[e] = sigmoidf_(aa[e]); kk[e] *= inv;
          kt[e] = k8[e] * (1.0f + (av[e] - 1.0f) * kac[e]); bb[e] = kk[e] * av[e]; bon_part += r8[e] * kt[e] * rkc[e]; }
#pragma unroll
      for (int off = 1; off < 64; off <<= 1) {
#pragma unroll
          for (int e = 0; e < 8; ++e) { const float up = __shfl_up(cum[e], off); cum[e] += (lane >= off) ? up : 0.f; } }
      float okq[8], orq[8], obk[8], okk[8], okb[8], obb[8];
#pragma unroll
      for (int e = 0; e < 8; ++e) { const float Lc = cum[e], LC = __shfl(cum[e], 63);
          const float ein = __expf(-Lc), eex = __expf(ew[e] - Lc), epl = __expf(Lc), erem = __expf(Lc - LC);
          okq[e] = kk[e] * eex; orq[e] = r8[e] * ein; obk[e] = bb[e] * epl; okk[e] = kt[e] * epl; okb[e] = kt[e] * erem; obb[e] = bb[e] * erem;
          if (tt == 0) gC[cg * 8 + e] = __expf(-LC); }
#define ST8(slot_, arr) *(LAS u32x4*)(slot(L, slot_) + tt * PITCH + cg * 8) = (u32x4){cvt_pk_bf16(arr[0], arr[1]), cvt_pk_bf16(arr[2], arr[3]), cvt_pk_bf16(arr[4], arr[5]), cvt_pk_bf16(arr[6], arr[7])}
      ST8(S_KQ, okq); ST8(S_RQ, orq); ST8(S_BK, obk); ST8(S_KK, okk); ST8(S_KBAR, okb); ST8(S_BBAR, obb); ST8(S_V, v8);
#undef ST8
      red2[tt * 8 + cg] = bon_part; }
    WKV_BAR();
    if (has_next) st_fetch(Z, nbh >> 4, nbh & 15, nc, tid, pf);
    KM_ISSUE(1);
    { float bt = 0.f;
#pragma unroll
      for (int e = 0; e < 8; ++e) bt += red2[tt * 8 + e];
      bf16_t* BV = (bf16_t*)(F.ws + WS_CBV) + uid * UNIT_E + tt * 64 + cg * 8; bf16_t* SG = (bf16_t*)(F.ws + WS_CSG) + uid * UNIT_E + tt * 64 + cg * 8;
      *(u32x4*)BV = (u32x4){cvt_pk_bf16(bt * v8[0], bt * v8[1]), cvt_pk_bf16(bt * v8[2], bt * v8[3]), cvt_pk_bf16(bt * v8[4], bt * v8[5]), cvt_pk_bf16(bt * v8[6], bt * v8[7])};
      *(u32x4*)SG = (u32x4){cvt_pk_bf16(siluf_(g8[0]), siluf_(g8[1])), cvt_pk_bf16(siluf_(g8[2]), siluf_(g8[3])), cvt_pk_bf16(siluf_(g8[4]), siluf_(g8[5])), cvt_pk_bf16(siluf_(g8[6]), siluf_(g8[7]))}; }
    const int tr_ = m0 + (lane & 15), sc0 = n0 + 4 * (lane >> 4);
    { bf16x8 akq[2], arq[2], bbk0[2], bbk1[2], bkk0[2], bkk1[2];
      frag_row(slot(L, S_KQ), m0, lane, akq); frag_row(slot(L, S_RQ), m0, lane, arq);
      frag_row(slot(L, S_BK), n0, lane, bbk0); frag_row(slot(L, S_BK), n0 + 16, lane, bbk1); frag_row(slot(L, S_KK), n0, lane, bkk0); frag_row(slot(L, S_KK), n0 + 16, lane, bkk1);
      f32x4 z = {0.f, 0.f, 0.f, 0.f}; f32x4 m_0 = z, m_1 = z, n_0 = z, n_1 = z, ay0 = z, ay1 = z, by0 = z, by1 = z;
      mma<true>(akq, bbk0, m_0); mma<true>(akq, bbk1, m_1); mma<true>(akq, bkk0, n_0); mma<true>(akq, bkk1, n_1);
      mma<true>(arq, bkk0, ay0); mma<true>(arq, bkk1, ay1); mma<true>(arq, bbk0, by0); mma<true>(arq, bbk1, by1);
      f32x4 x0, x1;
#pragma unroll
      for (int r = 0; r < 4; ++r) { const int s0 = sc0 + r, s1 = sc0 + 16 + r;
          m_0[r] = (s0 < tr_) ? m_0[r] : 0.f; m_1[r] = (s1 < tr_) ? m_1[r] : 0.f; n_0[r] = (s0 < tr_) ? n_0[r] : 0.f; n_1[r] = (s1 < tr_) ? n_1[r] : 0.f;
          ay0[r] = (s0 <= tr_) ? ay0[r] : 0.f; ay1[r] = (s1 <= tr_) ? ay1[r] : 0.f; by0[r] = (s0 <= tr_) ? by0[r] : 0.f; by1[r] = (s1 <= tr_) ? by1[r] : 0.f;
          x0[r] = ((s0 == tr_) ? 1.f : 0.f) - m_0[r]; x1[r] = ((s1 == tr_) ? 1.f : 0.f) - m_1[r]; }
      st_img(slot(L, S_M), m0, n0, lane, m_0); st_img(slot(L, S_M), m0, n0 + 16, lane, m_1); st_img(slot(L, S_N), m0, n0, lane, n_0); st_img(slot(L, S_N), m0, n0 + 16, lane, n_1);
      st_img(slot(L, S_AY), m0, n0, lane, ay0); st_img(slot(L, S_AY), m0, n0 + 16, lane, ay1); st_img(slot(L, S_BY), m0, n0, lane, by0); st_img(slot(L, S_BY), m0, n0 + 16, lane, by1);
      st_img(slot(L, S_X0), m0, n0, lane, x0); st_img(slot(L, S_X0), m0, n0 + 16, lane, x1); }
    WKV_BAR();
#define NEUMANN_ROUND(PIN, POUT, XIN, XOUT, DO_P, DO_X, DO_NV) do {                                                           \
        bf16x8 ap[2], ax[2], an[2], bp0[2], bp1[2], bv0[2], bv1[2]; TrRaw tp0, tp1, tv0, tv1; f32x4 x0, x1;                       \
        if (DO_P) frag_row(slot(L, PIN), m0, lane, ap);                                                                         \
        if (DO_X) { frag_row(slot(L, XIN), m0, lane, ax); x0 = ld_img(slot(L, XIN), m0, n0, lane); x1 = ld_img(slot(L, XIN), m0, n0 + 16, lane); } \
        if (DO_NV) frag_row(slot(L, S_N), m0, lane, an);                                                                        \
        tr_issue(slot(L, PIN), n0, lane, tp0); tr_issue(slot(L, PIN), n0 + 16, lane, tp1);                                      \
        if (DO_NV) { tr_issue(slot(L, S_V), n0, lane, tv0); tr_issue(slot(L, S_V), n0 + 16, lane, tv1); TR_WAIT4(tp0, tp1, tv0, tv1); } else { TR_WAIT2(tp0, tp1); } \
        tr_frag(tp0, bp0); tr_frag(tp1, bp1);                                                                                    \
        if (DO_P) { f32x4 p0 = {0.f, 0.f, 0.f, 0.f}, p1 = p0; mma<true>(ap, bp0, p0); mma<true>(ap, bp1, p1);                      \
                    st_img(slot(L, POUT), m0, n0, lane, p0); st_img(slot(L, POUT), m0, n0 + 16, lane, p1); }                      \
        if (DO_X) { mma<true>(ax, bp0, x0); mma<true>(ax, bp1, x1); st_img(slot(L, XOUT), m0, n0, lane, x0); st_img(slot(L, XOUT), m0, n0 + 16, lane, x1); } \
        if (DO_NV) { tr_frag(tv0, bv0); tr_frag(tv1, bv1); f32x4 v0 = {0.f, 0.f, 0.f, 0.f}, v1 = v0; mma<true>(an, bv0, v0); mma<true>(an, bv1, v1); \
                     st_img(slot(L, S_NV), m0, n0, lane, v0); st_img(slot(L, S_NV), m0, n0 + 16, lane, v1); }                       \
        WKV_BAR(); } while (0)
    NEUMANN_ROUND(S_M, S_BK, S_X0, S_X0, true, false, true);
    NEUMANN_ROUND(S_BK, S_M, S_X0, S_KK, true, true, false);
    KM_SUM(); KM_ISSUE(2);
    NEUMANN_ROUND(S_M, S_BK, S_KK, S_X0, true, true, false);
    NEUMANN_ROUND(S_BK, S_M, S_X0, S_KK, true, true, false);
    NEUMANN_ROUND(S_M, S_BK, S_KK, S_X0, true, true, false);
    KM_SUM(); KM_ISSUE(3);
    NEUMANN_ROUND(S_BK, S_M, S_X0, S_KK, false, true, false);
#undef NEUMANN_ROUND
    { bf16x8 at[2], b0[2], b1[2]; TrRaw t0, t1, t2, t3; frag_row(slot(L, S_KK), m0, lane, at);
      tr_issue(slot(L, S_KQ), n0, lane, t0); tr_issue(slot(L, S_KQ), n0 + 16, lane, t1); tr_issue(slot(L, S_NV), n0, lane, t2); tr_issue(slot(L, S_NV), n0 + 16, lane, t3);
      TR_WAIT4(t0, t1, t2, t3);
      tr_frag(t0, b0); tr_frag(t1, b1);
      f32x4 w0 = {0.f, 0.f, 0.f, 0.f}, w1 = w0; mma<true>(at, b0, w0); mma<true>(at, b1, w1);
      st_img(slot(L, S_M), m0, n0, lane, w0); st_img(slot(L, S_M), m0, n0 + 16, lane, w1);
      tr_frag(t2, b0); tr_frag(t3, b1);
      f32x4 u0 = {0.f, 0.f, 0.f, 0.f}, u1 = u0; mma<true>(at, b0, u0); mma<true>(at, b1, u1);
      st_img(slot(L, S_N), m0, n0, lane, -u0); st_img(slot(L, S_N), m0, n0 + 16, lane, -u1); }
    WKV_BAR();
    { const int c16 = lane & 15, q4 = 4 * (lane >> 4);
      bf16x8 a[2], a2[2], b0[2], b1[2], c0[2], c1[2];
      TrRaw tw, tbb0, tbb1, tv, tnu, tkb0, tkb1;
      tr_issue(slot(L, S_M), m0, lane, tw); tr_issue(slot(L, S_BBAR), n0, lane, tbb0); tr_issue(slot(L, S_BBAR), n0 + 16, lane, tbb1);
      tr_issue(slot(L, S_V), m0, lane, tv); tr_issue(slot(L, S_N), m0, lane, tnu); tr_issue(slot(L, S_KBAR), n0, lane, tkb0); tr_issue(slot(L, S_KBAR), n0 + 16, lane, tkb1);
      TR_WAIT7(tw, tbb0, tbb1, tv, tnu, tkb0, tkb1);
      tr_frag(tw, a); tr_frag(tbb0, b0); tr_frag(tbb1, b1);
      { f32x4 p0 = {0.f, 0.f, 0.f, 0.f}, p1 = p0; mma<false>(a, b0, p0); mma<false>(a, b1, p1);
#pragma unroll
        for (int r = 0; r < 4; ++r) { const int j = m0 + q4 + r; const float gd = gC[j]; p0[r] = ((j == n0 + c16) ? gd : 0.f) - p0[r]; p1[r] = ((j == n0 + 16 + c16) ? gd : 0.f) - p1[r]; }
        bf16_t* PT = (bf16_t*)(F.ws + WS_CPM) + uid * UNIT_E;
        *(u32x2*)(PT + (size_t)(n0 + c16) * 64 + m0 + q4) = pack4(p0); *(u32x2*)(PT + (size_t)(n0 + 16 + c16) * 64 + m0 + q4) = pack4(p1); }
      tr_frag(tv, a); tr_frag(tnu, a2); tr_frag(tkb0, c0); tr_frag(tkb1, c1);
      { f32x4 q0 = {0.f, 0.f, 0.f, 0.f}, q1 = q0; mma<true>(a, c0, q0); mma<true>(a, c1, q1); mma<true>(a2, b0, q0); mma<true>(a2, b1, q1);
        float* QG = (float*)(F.ws + WS_CQ) + uid * UNIT_E + (size_t)(m0 + c16) * 64 + n0 + q4; *(f32x4*)QG = q0; *(f32x4*)(QG + 16) = q1; }
      TrRaw tw0, tw1, tv0, tv1, tn0, tn1;
      frag_row(slot(L, S_BY), m0, lane, a); frag_row(slot(L, S_AY), m0, lane, a2);
      const f32x4 r0 = ld_img(slot(L, S_RQ), m0, n0, lane), r1 = ld_img(slot(L, S_RQ), m0, n0 + 16, lane);
      tr_issue(slot(L, S_M), n0, lane, tw0); tr_issue(slot(L, S_M), n0 + 16, lane, tw1); tr_issue(slot(L, S_V), n0, lane, tv0); tr_issue(slot(L, S_V), n0 + 16, lane, tv1);
      tr_issue(slot(L, S_N), n0, lane, tn0); tr_issue(slot(L, S_N), n0 + 16, lane, tn1);
      TR_WAIT6(tw0, tw1, tv0, tv1, tn0, tn1);
      tr_frag(tw0, b0); tr_frag(tw1, b1);
      { f32x4 y0 = {0.f, 0.f, 0.f, 0.f}, y1 = y0; mma<true>(a, b0, y0); mma<true>(a, b1, y1);
        bf16_t* YQ = (bf16_t*)(F.ws + WS_CYQ) + uid * UNIT_E + (size_t)(m0 + c16) * 64 + n0 + q4; *(u32x2*)YQ = pack4(r0 - y0); *(u32x2*)(YQ + 16) = pack4(r1 - y1); }
      tr_frag(tv0, b0); tr_frag(tv1, b1); tr_frag(tn0, c0); tr_frag(tn1, c1);
      { f32x4 y0 = {0.f, 0.f, 0.f, 0.f}, y1 = y0; mma<true>(a2, b0, y0); mma<true>(a2, b1, y1); mma<true>(a, c0, y0); mma<true>(a, c1, y1);
        float* YL = (float*)(F.ws + WS_CYL) + uid * UNIT_E + (size_t)(m0 + c16) * 64 + n0 + q4; *(f32x4*)YL = y0; *(f32x4*)(YL + 16) = y1; } }
    KM_SUM();
    *(f32x4*)kmdst = kacc;
#undef KM_ISSUE
#undef KM_SUM
    WKV_BAR();
}

__device__ __forceinline__ void scanB_unit(Frame& F, int unit) {
    int tid = F.tid; asm volatile("" : "+v"(tid));
    const int bh = unit >> 1, half = unit & 1;
    const int lane = tid & 63, wv = F.wave, ml0 = (wv & 1) * 16, m0 = half * 32 + ml0, n0 = (wv >> 1) * 16, c16 = lane & 15, q4 = 4 * (lane >> 4);
    LAS unsigned char* L = F.lds;
    const bf16_t* PT = (const bf16_t*)(F.ws + WS_CPM) + (size_t)bh * 64 * UNIT_E; const float* QG = (const float*)(F.ws + WS_CQ) + (size_t)bh * 64 * UNIT_E;
    bf16_t* SC = (bf16_t*)(F.ws + WS_CSC) + (size_t)bh * 64 * UNIT_E;
    f32x4 s = {0.f, 0.f, 0.f, 0.f};
    const size_t boff = (size_t)(n0 + c16) * 64 + 2 * q4, qoff = (size_t)(m0 + c16) * 64 + n0 + q4;
    bf16x8 P0[2], P1[2], P2[2], P3[2], P4[2], P5[2], P6[2], P7[2]; f32x4 Q0, Q1, Q2, Q3, Q4, Q5, Q6, Q7;
#define SB_LOAD(P, Q, cc) do { const int c_ = (cc) < 64 ? (cc) : 63; const bf16_t* PTn = PT + (size_t)c_ * UNIT_E + boff;                                  \
        P[0] = *(const bf16x8*)PTn; P[1] = *(const bf16x8*)(PTn + 32); Q = *(const f32x4*)(QG + (size_t)c_ * UNIT_E + qoff); } while (0)
#define SB_STEP(cc, P, Q) do { LAS bf16_t* simg = slot(L, (cc) & 1);                                                                                    \
        mfma_fence(s); const u32x2 w = pack4(s);                                                                                                         \
        *(LAS u32x2*)(simg + (ml0 + c16) * PITCH + n0 + q4) = w;                                                                                        \
        *(u32x2*)(SC + (size_t)(cc) * UNIT_E + (size_t)(m0 + c16) * 64 + n0 + q4) = w;                                                                   \
        asm volatile("s_waitcnt lgkmcnt(0)" ::: "memory"); __builtin_amdgcn_s_barrier(); asm volatile("" ::: "memory");                                 \
        bf16x8 a[2]; frag_row(simg, ml0, lane, a);                                                                                                        \
        s = Q; mma<true>(a, P, s);                                                                                                                        \
        SB_LOAD(P, Q, (cc) + 8); } while (0)
    SB_LOAD(P0, Q0, 0); SB_LOAD(P1, Q1, 1); SB_LOAD(P2, Q2, 2); SB_LOAD(P3, Q3, 3); SB_LOAD(P4, Q4, 4); SB_LOAD(P5, Q5, 5); SB_LOAD(P6, Q6, 6); SB_LOAD(P7, Q7, 7);
    for (int c = 0; c < 64; c += 8) {
        SB_STEP(c, P0, Q0); SB_STEP(c + 1, P1, Q1); SB_STEP(c + 2, P2, Q2); SB_STEP(c + 3, P3, Q3);
        SB_STEP(c + 4, P4, Q4); SB_STEP(c + 5, P5, Q5); SB_STEP(c + 6, P6, Q6); SB_STEP(c + 7, P7, Q7);
    }
#undef SB_LOAD
#undef SB_STEP
    mfma_fence(s);
    *(f32x4*)(F.out + O_WKP + (size_t)bh * 4096 + (size_t)(m0 + c16) * 64 + n0 + q4) = s;
    WKV_BAR();
}

__device__ __forceinline__ void scanC_unit(Frame& F, int bh, int c) {
    int tid = F.tid; asm volatile("" : "+v"(tid));
    const int lane = tid & 63, wv = F.wave, mt = wv & 3, ntp = wv >> 2, m0 = mt * 16, n0 = ntp * 32, c16 = lane & 15, q4 = 4 * (lane >> 4);
    const size_t uid = (size_t)bh * 64 + c; const int b = bh >> 4, h = bh & 15;
    LAS float* Yf = (LAS float*)F.lds;
    const bf16_t* YQ = (const bf16_t*)(F.ws + WS_CYQ) + uid * UNIT_E; const bf16_t* SC = (const bf16_t*)(F.ws + WS_CSC) + uid * UNIT_E; const float* YL = (const float*)(F.ws + WS_CYL) + uid * UNIT_E;
    bf16x8 a[2], b0[2], b1[2];
    { const bf16_t* ap = YQ + (size_t)(m0 + c16) * 64 + 2 * q4; a[0] = *(const bf16x8*)ap; a[1] = *(const bf16x8*)(ap + 32);
      const bf16_t* bp = SC + (size_t)(n0 + c16) * 64 + 2 * q4; b0[0] = *(const bf16x8*)bp; b0[1] = *(const bf16x8*)(bp + 32); b1[0] = *(const bf16x8*)(bp + 16 * 64); b1[1] = *(const bf16x8*)(bp + 16 * 64 + 32); }
    f32x4 y0 = *(const f32x4*)(YL + (size_t)(m0 + c16) * 64 + n0 + q4), y1 = *(const f32x4*)(YL + (size_t)(m0 + c16) * 64 + n0 + 16 + q4);
    mma<true>(a, b0, y0); mma<true>(a, b1, y1);
    *(LAS f32x4*)(Yf + (m0 + c16) * 68 + n0 + q4) = y0; *(LAS f32x4*)(Yf + (m0 + c16) * 68 + n0 + 16 + q4) = y1;
    WKV_BAR();
    { const int tt = tid >> 3, ig = tid & 7; float y[8];
      const f32x4 ya = *(const LAS f32x4*)(Yf + tt * 68 + ig * 8), yb = *(const LAS f32x4*)(Yf + tt * 68 + ig * 8 + 4);
      y[0] = ya.x; y[1] = ya.y; y[2] = ya.z; y[3] = ya.w; y[4] = yb.x; y[5] = yb.y; y[6] = yb.z; y[7] = yb.w;
      float s = 0.f;
#pragma unroll
      for (int e = 0; e < 8; ++e) s += y[e];
      s += __shfl_xor(s, 1); s += __shfl_xor(s, 2); s += __shfl_xor(s, 4);
      const float mean = s * (1.f / 64.f); float vq = 0.f;
#pragma unroll
      for (int e = 0; e < 8; ++e) { y[e] -= mean; vq += y[e] * y[e]; }
      vq += __shfl_xor(vq, 1); vq += __shfl_xor(vq, 2); vq += __shfl_xor(vq, 4);
      const float rstd = 1.0f / sqrtf(vq * (1.f / 64.f) + GN_EPS);
      float lw[8], lb[8], bv[8], sg[8];
      ld8f(F.lnx_w + h * 64 + ig * 8, lw); ld8f(F.lnx_b + h * 64 + ig * 8, lb);
      ld8bf((const bf16_t*)(F.ws + WS_CBV) + uid * UNIT_E + tt * 64 + ig * 8, bv); ld8bf((const bf16_t*)(F.ws + WS_CSG) + uid * UNIT_E + tt * 64 + ig * 8, sg);
      float o[8];
#pragma unroll
      for (int e = 0; e < 8; ++e) o[e] = (y[e] * rstd * lw[e] + lb[e] + bv[e]) * sg[e];
      bf16_t* OA = (bf16_t*)(F.ws + WS_OA) + ((size_t)b * TSEQ + c * 64 + tt) * 1024 + h * 64 + ig * 8;
      *(u32x4*)OA = (u32x4){cvt_pk_bf16(o[0], o[1]), cvt_pk_bf16(o[2], o[3]), cvt_pk_bf16(o[4], o[5]), cvt_pk_bf16(o[6], o[7])}; }
    WKV_BAR();
}
}
#ifndef MK_N_LAUNCHES
#define MK_N_LAUNCHES 1
#endif
constexpr int N_PHASES = 8;
#ifndef REP0
#define REP0 1
#endif
#ifndef REP1
#define REP1 1
#endif
#ifndef REP2
#define REP2 1
#endif
#ifndef REP3
#define REP3 1
#endif
#ifndef REP4
#define REP4 1
#endif
#ifndef REP5
#define REP5 1
#endif
#ifndef REP6
#define REP6 1
#endif
__device__ __forceinline__ void phase1(Frame& F) {
    pg8::Gemm g{(const bf16_t*)(F.ws + WS_XN), (const bf16_t*)(F.ws + WS_WINT), MP, ZC_WLO, DM}; pg8::StaticOrder S; S.init(MP, ZC_WLO, F.G, F.bid);
    pg8::EpiIn E{(bf16_t*)(F.ws + WS_Z), F.out + O_KP, F.out + O_VP, (float*)(F.ws + WS_KMP), (const float*)(F.ws + WS_ROPE)};
    pg8::gemm_phase<pg8::EpiIn, pg8::StaticOrder, true, true>(F.lds, g, S, E);
    for (int u = F.bid; u < MP / 32; u += F.G) lora_unit(F, u);
    phase_inproj_sample(F);
}
__device__ __forceinline__ void phase2(Frame& F) {
    { int last_bh = -1; u32x4 pf[7];
      const int cq = F.tid & 255, rg = F.tid >> 8;
      int phys = 0;
      if (F.bid < 2048) { const int j = F.bid & 255, k = F.bid >> 8; wkv::st_fetch((const bf16_t*)(F.ws + WS_Z), (j >> 3) >> 4, (j >> 3) & 15, (j & 7) + 8 * k, F.tid, pf);
          const int uid0 = (j >> 3) * 64 + (j & 7) + 8 * k; phys = F.page_table[uid0 >> 1]; }
      for (int u = F.bid; u < 2048; u += F.G) { const int j = u & 255, k = u >> 8, bh = j >> 3, c = (j & 7) + 8 * k, uid = bh * 64 + c;
          const int un = u + F.G, jn = un & 255, kn = un >> 8, uidn = (jn >> 3) * 64 + (jn & 7) + 8 * kn;
          const int physn = (un < 2048) ? F.page_table[uidn >> 1] : 0;
          const float* kmsrc = F.cache_k + ((size_t)phys * PAGE + (uid & 1) * 64 + rg) * 1024 + cq * 4;
          float* kmdst = (float*)(F.ws + WS_KMS) + ((size_t)uid * 2 + rg) * 1024 + cq * 4;
          wkv::scanA_unit(F, bh, c, bh != last_bh, pf, jn >> 3, (jn & 7) + 8 * kn, un < 2048, kmsrc, kmdst); last_bh = bh; phys = physn; } }
    for (int u = F.bid; u < 240; u += F.G) moba_select_unit(F, u);
}
__device__ __forceinline__ void phase3(Frame& F) {
    moba_past_phase(F, F.G > 64 ? F.G - 64 : F.G);
    __syncthreads();
    for (int u = F.G - 1 - F.bid; u < 64; u += F.G) wkv::scanB_unit(F, u);
    for (int u = ((2 * F.G - 65 - F.bid) % F.G) * NWAVES + F.wave; u < 128; u += F.G * NWAVES) sample_wkv_unit(F, u, (LAS float*)F.lds + 4096 + F.wave * 512);
}
__device__ __forceinline__ void phase4(Frame& F) {
    for (int u = F.bid; u < 2048; u += F.G) wkv::scanC_unit(F, u >> 6, u & 63);
    for (int u = F.bid; u < 256; u += F.G) moba_own(F, u);
    for (int u = F.G - 1 - F.bid; u < 64; u += F.G) sample_attn_unit(F, u);
}
__device__ __forceinline__ void phase5(Frame& F) {
    { pg8::Gemm g{(const bf16_t*)(F.ws + WS_OA), (const bf16_t*)(F.ws + WS_PAT), MP, DM, DA}; pg8::StaticOrder S; S.init(MP, DM, F.G, F.bid);
      pg8::EpiMrgA E{(const bf16_t*)(F.ws + WS_Z), (float*)(F.ws + WS_TMP)};
      pg8::gemm_phase<pg8::EpiMrgA, pg8::StaticOrder, true, true>(F.lds, g, S, E); }
    { pg8::Gemm g{(const bf16_t*)(F.ws + WS_OB), (const bf16_t*)(F.ws + WS_PBT), MP, DM, DBB}; pg8::StaticOrder S; S.init(MP, DM, F.G, F.bid);
      pg8::EpiMrgB E{(const bf16_t*)(F.ws + WS_Z), (const float*)(F.ws + WS_TMP), (bf16_t*)(F.ws + WS_MRG)};
      pg8::gemm_phase<pg8::EpiMrgB, pg8::StaticOrder, true, true>(F.lds, g, S, E); }
    phase_merge_sample(F);
}
__device__ __forceinline__ void phase6(Frame& F) {
    pg8::Gemm g{(const bf16_t*)(F.ws + WS_MRG), (const bf16_t*)(F.ws + WS_WOT), MP, DM, DM}; pg8::StaticOrder S; S.init(MP, DM, F.G, F.bid);
    pg8::EpiRes E{F.x_p, F.out + O_YP};
    pg8::gemm_phase<pg8::EpiRes, pg8::StaticOrder, true, true>(F.lds, g, S, E);
    phase_out_sample(F);
}
__global__ void __launch_bounds__(NTHR, 2) fwd_kernel(Args args) {
    extern __shared__ __attribute__((aligned(16))) unsigned char lds[];
    Frame F;
    F.lds = (LAS unsigned char*)lds; F.ldsg = (char*)lds;
    F.tid = threadIdx.x; F.lane = F.tid & 63; F.wave = __builtin_amdgcn_readfirstlane(F.tid >> 6); F.G = gridDim.x; F.bid = blockIdx.x;
    F.x_p = (const float*)args.in[0]; F.x_s = (const float*)args.in[1]; F.st_shift = (const float*)args.in[2]; F.st_wkv = (const float*)args.in[3];
    F.cache_k = (const float*)args.in[4]; F.cache_v = (const float*)args.in[5]; F.page_table = (const int*)args.in[6];
    F.ln_w = (const float*)args.in[7]; F.w_in = (const float*)args.in[8]; F.mu = (const float*)args.in[9]; F.w0 = (const float*)args.in[10]; F.w2 = (const float*)args.in[11];
    F.a0 = (const float*)args.in[12]; F.a2 = (const float*)args.in[13]; F.k_k = (const float*)args.in[14]; F.k_a = (const float*)args.in[15]; F.r_k = (const float*)args.in[16];
    F.lnx_w = (const float*)args.in[17]; F.lnx_b = (const float*)args.in[18]; F.p_a = (const float*)args.in[19]; F.p_b = (const float*)args.in[20]; F.w_o = (const float*)args.in[21];
    F.final_w = (const float*)args.in[22]; F.out = args.out; F.ws = args.ws;
    volatile LAS unsigned* MISC = (volatile LAS unsigned*)(F.lds + MISC_OFF);
    for (int u = F.tid; u < (LDS_BYTES - LDSCTL_OFF) / 4; u += NTHR) ((LAS unsigned*)(F.lds + LDSCTL_OFF))[u] = 0u;
    __syncthreads();
    const int lo = args.ph_lo, hi = args.ph_hi;
    XcdBarrier bar; bar.bar = (unsigned*)(F.ws + WS_CTL) + CW_BAR; bar.x = 0; bar.st = MISC + 8;
    if (hi - lo > 1) bar = xcd_barrier_post((unsigned*)(F.ws + WS_CTL) + CW_BAR, MISC + 8);
#define IN(k) (lo <= (k) && (k) < hi)
#define SEAM(k) do { if (IN(k) && IN((k) + 1)) xcd_barrier(bar); } while (0)

    if (IN(0)) { phase_prologue(F); if (REP0 > 1) { xcd_barrier(bar); phase_prologue(F); } }
    SEAM(0);
    if (IN(1)) { phase1(F); if (REP1 > 1) { xcd_barrier(bar); phase1(F); } }
    SEAM(1);
    if (IN(2)) { phase2(F); if (REP2 > 1) { xcd_barrier(bar); phase2(F); } }
    SEAM(2);
    if (IN(3)) { phase3(F); if (REP3 > 1) { xcd_barrier(bar); phase3(F); } }
    SEAM(3);
    if (IN(4)) { phase4(F); if (REP4 > 1) { xcd_barrier(bar); phase4(F); } }
    SEAM(4);
    if (IN(5)) { phase5(F); if (REP5 > 1) { xcd_barrier(bar); phase5(F); } }
    SEAM(5);
    if (IN(6)) { phase6(F); if (REP6 > 1) { xcd_barrier(bar); phase6(F); } }
    SEAM(6);
    if (IN(7)) {
        for (int r = F.bid * NWAVES + F.wave; r < MP + DECB; r += F.G * NWAVES) final_norm_row(F, r < MP ? F.out + O_YP + (size_t)r * DM : F.out + O_YS + (size_t)(r - MP) * DM);
    }
#undef IN
#undef SEAM
}

extern "C" void kernel_launch(void* const* d_in, const int* in_sizes, int n_in, void* d_out, int out_size, void* d_ws, size_t ws_size, hipStream_t stream) {
    static int grid = 0;
    if (grid == 0) {
        if (n_in != 23 || (size_t)out_size != O_END || ws_size < WS_END) { fprintf(stderr, "kernel_launch: unexpected shapes: n_in %d out %d ws %zu; nothing launched\n", n_in, out_size, ws_size); grid = -1; return; }
        int dev = 0, cus = 0, per_cu = 0;
        if (hipGetDevice(&dev) != hipSuccess || hipDeviceGetAttribute(&cus, hipDeviceAttributeMultiprocessorCount, dev) != hipSuccess) { grid = -1; return; }
        if (hipFuncSetAttribute((const void*)fwd_kernel, hipFuncAttributeMaxDynamicSharedMemorySize, LDS_BYTES) != hipSuccess) { fprintf(stderr, "kernel_launch: hipFuncSetAttribute failed\n"); grid = -1; return; }
        if (hipOccupancyMaxActiveBlocksPerMultiprocessor(&per_cu, (const void*)fwd_kernel, NTHR, LDS_BYTES) != hipSuccess || per_cu < 1)
            fprintf(stderr, "kernel_launch: note: occupancy query reports %d workgroups per CU\n", per_cu);
        (void)hipGetLastError();
        grid = cus;
    }
    if (grid < 0) return;
    if (hipMemsetAsync((char*)d_ws + WS_CTL, 0, CTL_ZERO_BYTES, stream) != hipSuccess) { fprintf(stderr, "kernel_launch: memset failed\n"); return; }
    Args a{};
    for (int i = 0; i < 23; ++i) a.in[i] = d_in[i];
    a.out = (float*)d_out; a.ws = (unsigned char*)d_ws;
    constexpr int NL = MK_N_LAUNCHES;
    for (int li = 0; li < NL; ++li) {
        a.ph_lo = li * N_PHASES / NL; a.ph_hi = (li + 1) * N_PHASES / NL;
        hipLaunchKernelGGL(fwd_kernel, dim3(grid), dim3(NTHR), LDS_BYTES, stream, a);
        const hipError_t le = hipPeekAtLastError();
        if (le != hipSuccess) { fprintf(stderr, "kernel_launch: launch %d failed: %s\n", li, hipGetErrorName(le)); break; }
    }
}
```

```cpp
#include <hip/hip_runtime.h>
#include <cstdio>
#include <cstdint>

#define GAS __attribute__((address_space(1)))
#define LAS __attribute__((address_space(3)))
typedef unsigned short bf16_t;
typedef short bf16x8 __attribute__((ext_vector_type(8)));
typedef short s16x4 __attribute__((ext_vector_type(4)));
typedef float f32x2 __attribute__((ext_vector_type(2)));
typedef float f32x4 __attribute__((ext_vector_type(4)));
typedef float f32x16 __attribute__((ext_vector_type(16)));
typedef unsigned u32x2 __attribute__((ext_vector_type(2)));
typedef unsigned u32x4 __attribute__((ext_vector_type(4)));

constexpr int DM = 2048, NBATCH = 2, TSEQ = 4096, MP = NBATCH * TSEQ;
constexpr int DECB = 8, PAST = 16384, PAGE = 128, NPG = PAST / PAGE;
constexpr int DA = 1024, HA = 16, NA = 64;
constexpr int DBB = 1024, HB = 8, HD = 128;
constexpr int NIN = 12416, ZLD = 12544;
constexpr int RWC = 4224;
constexpr int ZC_R = 0, ZC_K = 1024, ZC_V = 2048, ZC_G = 3072, ZC_Q = 4096, ZC_KB = 5120, ZC_VB = 6144, ZC_GB = 7168, ZC_GATE = 8192, ZC_WLO = 12288, ZC_ALO = 12352;
constexpr size_t O_YP = 0, O_YS = 16777216, O_SHP = O_YS + 16384, O_WKP = O_SHP + 4096, O_KP = O_WKP + 131072, O_VP = O_KP + 8388608,
                 O_SHS = O_VP + 8388608, O_WKS = O_SHS + 16384, O_KS = O_WKS + 524288, O_VS = O_KS + 8192, O_END = O_VS + 8192;
constexpr float NORM_EPS = 1e-6f, GN_EPS = 64e-5f;

__host__ __device__ inline int zcol_to_src(int c) {
    if (c < 1024) return c;
    if (c < 2048) return 1088 + (c - 1024);
    if (c < 3072) return 2112 + (c - 2048);
    if (c < 4096) return 3200 + (c - 3072);
    if (c < 8192) return 4224 + (c - 4096);
    if (c < 12288) return 8320 + (c - 8192);
    if (c < 12352) return 1024 + (c - 12288);
    if (c < 12416) return 3136 + (c - 12352);
    return -1;
}

__host__ __device__ inline int perm32inv(int c) { return 16 * ((c >> 2) & 1) + 4 * (c >> 3) + (c & 3); }
__host__ __device__ inline int wrow(int c) { const int l = c & 255; return (c & ~255) + 128 * ((l >> 5) & 1) + 32 * (l >> 6) + perm32inv(l & 31); }
__host__ __device__ inline int wrow_in(int c) { return c < 12288 ? wrow(c) : c; }

__device__ __forceinline__ unsigned cvt_pk_bf16(float lo, float hi) { unsigned r; asm volatile("v_cvt_pk_bf16_f32 %0, %1, %2" : "=v"(r) : "v"(lo), "v"(hi)); return r; }
__device__ __forceinline__ float bf2f(unsigned short b) { return __uint_as_float(((unsigned)b) << 16); }
__device__ __forceinline__ float bflo(unsigned w) { return __uint_as_float(w << 16); }
__device__ __forceinline__ float bfhi(unsigned w) { return __uint_as_float(w & 0xffff0000u); }
__device__ __forceinline__ float sigmoidf_(float x) { return __builtin_amdgcn_rcpf(1.0f + __builtin_amdgcn_exp2f(-1.4426950408889634f * x)); }
__device__ __forceinline__ float siluf_(float x) { return x * sigmoidf_(x); }
__device__ __forceinline__ float wave_sum(float v) {
#pragma unroll
    for (int o = 1; o < 64; o <<= 1) v += __shfl_xor(v, o);
    return v;
}
__device__ __forceinline__ float wave_max(float v) {
#pragma unroll
    for (int o = 1; o < 64; o <<= 1) v = fmaxf(v, __shfl_xor(v, o));
    return v;
}
__device__ __forceinline__ void mfma_fence4(f32x4& v) { asm volatile("s_nop 7\n\ts_nop 7" : "+v"(v)); }
#define LDS_WAIT() asm volatile("s_waitcnt lgkmcnt(0)" ::: "memory")
#define VM_WAIT() asm volatile("s_waitcnt vmcnt(0)" ::: "memory")
__device__ __forceinline__ void ld8bf(const bf16_t* p, float (&o)[8]) {
    const u32x4 w = *(const u32x4*)p;
    o[0] = bflo(w.x); o[1] = bfhi(w.x); o[2] = bflo(w.y); o[3] = bfhi(w.y); o[4] = bflo(w.z); o[5] = bfhi(w.z); o[6] = bflo(w.w); o[7] = bfhi(w.w);
}
__device__ __forceinline__ void ld8bf_lds(const LAS bf16_t* p, float (&o)[8]) {
    const u32x4 w = *(const LAS u32x4*)p;
    o[0] = bflo(w.x); o[1] = bfhi(w.x); o[2] = bflo(w.y); o[3] = bfhi(w.y); o[4] = bflo(w.z); o[5] = bfhi(w.z); o[6] = bflo(w.w); o[7] = bfhi(w.w);
}
__device__ __forceinline__ void ld8f(const float* p, float (&o)[8]) {
    const f32x4 a = *(const f32x4*)p, b = *(const f32x4*)(p + 4);
    o[0] = a.x; o[1] = a.y; o[2] = a.z; o[3] = a.w; o[4] = b.x; o[5] = b.y; o[6] = b.z; o[7] = b.w;
}
__device__ __forceinline__ void ld8f_lds(const LAS float* p, float (&o)[8]) {
    const f32x4 a = *(const LAS f32x4*)p, b = *(const LAS f32x4*)(p + 4);
    o[0] = a.x; o[1] = a.y; o[2] = a.z; o[3] = a.w; o[4] = b.x; o[5] = b.y; o[6] = b.z; o[7] = b.w;
}
__device__ __forceinline__ void st8f(float* p, const float (&o)[8]) {
    *(f32x4*)p = (f32x4){o[0], o[1], o[2], o[3]}; *(f32x4*)(p + 4) = (f32x4){o[4], o[5], o[6], o[7]};
}
namespace pg8 {
#define PG8_LAS __attribute__((address_space(3)))
typedef unsigned short bf16_t;
typedef short bf16x8 __attribute__((ext_vector_type(8)));
typedef float f32x4 __attribute__((ext_vector_type(4)));
typedef unsigned u32x4 __attribute__((ext_vector_type(4)));
constexpr int BM = 256, BK = 64, HALF = 128, HTB = HALF * BK * 2  , STAGE_BYTES = 8 * HTB, NXCD = 8, WGM = 8;

__host__ __device__ __forceinline__ int lds_byte(int r, int c) { const int st = (r >> 4) * 2 + (c >> 5), rr = r & 15, cc = c & 31, ob = rr * 64 + cc * 2; return st * 1024 + (ob ^ (((ob >> 9) & 1) << 5)); }
__host__ __device__ __forceinline__ void stage_rc(int b, int& R, int& C) { const int st = b / 1024, sb = b % 1024, swz = sb ^ (((sb >> 9) & 1) << 5); R = (st >> 1) * 16 + swz / 64; C = (st & 1) * 32 + (swz % 64) / 2; }
__host__ __device__ __forceinline__ int perm32(int rho) { const int n = rho >> 4, i = rho & 15; return 8 * (i >> 2) + 4 * n + (i & 3); }

struct Unit { int pm, pn; };
struct Gemm { const bf16_t* A; const bf16_t* Bt; int M, N, K; };

struct StaticOrder {
    int nM, nN, nwg, G, c;
    __host__ __device__ void init(int M, int N, int G_, int c_) { nM = M / BM; nN = N / BM; nwg = nM * nN; G = G_; c = c_; }
    __host__ __device__ bool next(int i, Unit& u) const {
        const long L = (long)i * G + c; if (L >= nwg) return false;
        int wgid = (int)L; { const int q = nwg / NXCD, r = nwg % NXCD, xcd = wgid % NXCD, off = wgid / NXCD; wgid = (xcd < r ? xcd * (q + 1) : r * (q + 1) + (xcd - r) * q) + off; }
        const int nig = WGM * nN, gid = wgid / nig, fm = gid * WGM, gsz = (nM - fm) < WGM ? (nM - fm) : WGM;
        u.pm = fm + ((wgid % nig) % gsz); u.pn = (wgid % nig) / gsz; return true;
    }
    __device__ __forceinline__ void a_ready(const Unit&) const {}
    __device__ __forceinline__ void done(const Unit&) const {}
};
__device__ __forceinline__ u32x4 pk8(f32x4 a, f32x4 b) { u32x4 w; w.x = cvt_pk_bf16(a[0], a[1]); w.y = cvt_pk_bf16(a[2], a[3]); w.z = cvt_pk_bf16(b[0], b[1]); w.w = cvt_pk_bf16(b[2], b[3]); return w; }
struct EpiIn {
    static constexpr bool PERM = false, AFTER_DRAIN = false;
    bf16_t* Z; float* kout; float* vout; float* kmp; const float* rope;
    __device__ __forceinline__ void operator()(const f32x4 (&acc)[2][2][4][2], const Unit& u, int wr, int wc, int fr, int fq) const {
        const int pn = u.pn, row0 = u.pm * BM + wr * 64 + fr, col0 = pn * BM + wc * 64 + 8 * fq;
        const bool is_rope = (pn >= 16 && pn < 24) && ((wc & 1) == 0);
        const bool is_k = (pn >= 20 && pn < 24), is_v = (pn >= 24 && pn < 28), is_silu = (pn >= 28 && pn < 32), is_sig = (pn >= 32 && pn < 48);
        float* fout = is_k ? kout : vout; const int fcol0 = (pn - (is_k ? 20 : 24)) * BM + wc * 64 + 8 * fq;
        const float rsgn = (fq < 2) ? -1.0f : 1.0f;
        f32x4 ks[2][2];
#pragma unroll
        for (int bj = 0; bj < 2; ++bj)
#pragma unroll
            for (int n = 0; n < 2; ++n) ks[bj][n] = (f32x4){0.f, 0.f, 0.f, 0.f};
#pragma unroll
        for (int ai = 0; ai < 2; ++ai)
#pragma unroll
            for (int m = 0; m < 4; ++m) {
                const int row = row0 + ai * HALF + m * 16;
                bf16_t* zrow = Z + (size_t)row * ZLD + col0;
#pragma unroll
                for (int bj = 0; bj < 2; ++bj) {
                    f32x4 v0 = acc[ai][bj][m][0], v1 = acc[ai][bj][m][1];
                    if (bj == 0 && is_rope) {
                        const float* rp = rope + (size_t)(row & 4095) * 32 + 8 * (fq & 1);
                        const f32x4 c0 = *(const f32x4*)rp, c1 = *(const f32x4*)(rp + 4), s0 = *(const f32x4*)(rp + 16), s1 = *(const f32x4*)(rp + 20);
                        f32x4 o0, o1;
#pragma unroll
                        for (int j = 0; j < 4; ++j) { o0[j] = __shfl_xor(v0[j], 32); o1[j] = __shfl_xor(v1[j], 32); }
                        v0 = v0 * c0 + o0 * s0 * rsgn; v1 = v1 * c1 + o1 * s1 * rsgn;
                    }
                    if (is_silu) {
#pragma unroll
                        for (int j = 0; j < 4; ++j) { v0[j] = siluf_(v0[j]); v1[j] = siluf_(v1[j]); } }
                    if (is_sig) {
#pragma unroll
                        for (int j = 0; j < 4; ++j) { v0[j] = sigmoidf_(v0[j]); v1[j] = sigmoidf_(v1[j]); } }
                    *(u32x4*)(zrow + bj * 32) = pk8(v0, v1);
                    if (is_k || is_v) { float* fp = fout + (size_t)row * 1024 + fcol0 + bj * 32; *(f32x4*)fp = v0; *(f32x4*)(fp + 4) = v1; }
                    if (is_k) { ks[bj][0] += v0; ks[bj][1] += v1; }
                }
            }
        if (is_k) {
#pragma unroll
            for (int bj = 0; bj < 2; ++bj)
#pragma unroll
                for (int n = 0; n < 2; ++n) {
                    f32x4 s = ks[bj][n];
#pragma unroll
                    for (int o = 1; o < 16; o <<= 1) { s[0] += __shfl_xor(s[0], o); s[1] += __shfl_xor(s[1], o); s[2] += __shfl_xor(s[2], o); s[3] += __shfl_xor(s[3], o); }
                    if (fr == 0) *(f32x4*)(kmp + (size_t)(u.pm * 2 + wr) * 1024 + fcol0 + bj * 32 + n * 4) = s;
                }
        }
    }
};
struct EpiMrgA {
    static constexpr bool PERM = false, AFTER_DRAIN = false;
    const bf16_t* Z; bf16_t* tmp;
    __device__ __forceinline__ void operator()(const f32x4 (&acc)[2][2][4][2], const Unit& u, int wr, int wc, int fr, int fq) const {
        const int row0 = u.pm * BM + wr * 64 + fr, col0 = u.pn * BM + wc * 64 + 8 * fq;
#pragma unroll
        for (int ai = 0; ai < 2; ++ai)
#pragma unroll
            for (int m = 0; m < 4; ++m) { const int row = row0 + ai * HALF + m * 16; const bf16_t* gp = Z + (size_t)row * ZLD + ZC_GATE + col0; bf16_t* tp = tmp + (size_t)row * DM + col0;
#pragma unroll
                for (int bj = 0; bj < 2; ++bj) { const u32x4 g = *(const u32x4*)(gp + bj * 32); const f32x4 a = acc[ai][bj][m][0], b = acc[ai][bj][m][1];
                    *(u32x4*)(tp + bj * 32) = pk8((f32x4){a[0] * bflo(g.x), a[1] * bfhi(g.x), a[2] * bflo(g.y), a[3] * bfhi(g.y)}, (f32x4){b[0] * bflo(g.z), b[1] * bfhi(g.z), b[2] * bflo(g.w), b[3] * bfhi(g.w)}); } }
    }
};
struct EpiMrgB {
    static constexpr bool PERM = false, AFTER_DRAIN = false;
    const bf16_t* Z; const bf16_t* tmp; bf16_t* mrg;
    __device__ __forceinline__ void operator()(const f32x4 (&acc)[2][2][4][2], const Unit& u, int wr, int wc, int fr, int fq) const {
        const int row0 = u.pm * BM + wr * 64 + fr, col0 = u.pn * BM + wc * 64 + 8 * fq;
#pragma unroll
        for (int ai = 0; ai < 2; ++ai)
#pragma unroll
            for (int m = 0; m < 4; ++m) { const int row = row0 + ai * HALF + m * 16; const bf16_t* gp = Z + (size_t)row * ZLD + ZC_GATE + DM + col0; const bf16_t* tp = tmp + (size_t)row * DM + col0;
                bf16_t* op = mrg + (size_t)row * DM + col0;
#pragma unroll
                for (int bj = 0; bj < 2; ++bj) { const u32x4 g = *(const u32x4*)(gp + bj * 32); const f32x4 a = acc[ai][bj][m][0], b = acc[ai][bj][m][1];
                    const u32x4 t = *(const u32x4*)(tp + bj * 32);
                    const f32x4 r0 = (f32x4){bflo(t.x) + a[0] * bflo(g.x), bfhi(t.x) + a[1] * bfhi(g.x), bflo(t.y) + a[2] * bflo(g.y), bfhi(t.y) + a[3] * bfhi(g.y)};
                    const f32x4 r1 = (f32x4){bflo(t.z) + b[0] * bflo(g.z), bfhi(t.z) + b[1] * bfhi(g.z), bflo(t.w) + b[2] * bflo(g.w), bfhi(t.w) + b[3] * bfhi(g.w)};
                    *(u32x4*)(op + bj * 32) = pk8(r0, r1); } }
    }
};
struct EpiRes {
    static constexpr bool PERM = false, AFTER_DRAIN = false;
    const float* x; float* out;
    __device__ __forceinline__ void operator()(const f32x4 (&acc)[2][2][4][2], const Unit& u, int wr, int wc, int fr, int fq) const {
        const int row0 = u.pm * BM + wr * 64 + fr, col0 = u.pn * BM + wc * 64 + 8 * fq;
#pragma unroll
        for (int ai = 0; ai < 2; ++ai)
#pragma unroll
            for (int m = 0; m < 4; ++m) { const size_t off = (size_t)(row0 + ai * HALF + m * 16) * DM + col0;
#pragma unroll
                for (int bj = 0; bj < 2; ++bj) { *(f32x4*)(out + off + bj * 32) = *(const f32x4*)(x + off + bj * 32) + acc[ai][bj][m][0]; *(f32x4*)(out + off + bj * 32 + 4) = *(const f32x4*)(x + off + bj * 32 + 4) + acc[ai][bj][m][1]; } }
    }
};
template <class Epi, class Sched, bool ALIGN_EPI = false, bool SP2 = false>
__device__ __forceinline__ void gemm_phase(PG8_LAS unsigned char* lds, const Gemm g, const Sched& S, const Epi& E) {
    const int tid = threadIdx.x, wid = __builtin_amdgcn_readfirstlane(tid >> 6), lane = tid & 63, wr = wid >> 2, wc = wid & 3, fr = lane & 15, fq = lane >> 4;
    const int K = g.K, nt = K / BK;
    unsigned voffA[2], voffB[2];
#pragma unroll
    for (int i = 0; i < 2; ++i) { int R, C; stage_rc(tid * 16 + i * 8192, R, C); const int Rb = Epi::PERM ? ((R & ~31) + perm32(R & 31)) : R;
        voffA[i] = (unsigned)(R * K + C) * 2u; voffB[i] = (unsigned)(Rb * K + C) * 2u; }
    const size_t kstep = (size_t)(BK * 2);
    const size_t hstep = (size_t)HALF * K * 2;
    const size_t tstep = 2 * hstep;
    const unsigned ldsw = (unsigned)wid * 1024u;
    const int aoff = lds_byte(wr * 64 + fr, fq * 8), boff = lds_byte(wc * 32 + fr, fq * 8);
#define PG8_SA(b, h) (((b) * 2 + (h)) * HTB)
#define PG8_SB(b, h) ((4 + (b) * 2 + (h)) * HTB)
#define PG8_STAGE(bufoff, gbase, voff) do { _Pragma("unroll") for (int _i = 0; _i < 2; ++_i) \
        __builtin_amdgcn_global_load_lds((const unsigned*)((const char*)(gbase) + (voff)[_i]), (PG8_LAS unsigned*)(lds + (bufoff) + ldsw + _i * 8192), 16, 0, 0); } while (0)
#define PG8_LDA(dst, b, h) do { _Pragma("unroll") for (int m = 0; m < 4; ++m) _Pragma("unroll") for (int k = 0; k < 2; ++k) dst[m][k] = *(const PG8_LAS bf16x8*)(lds + PG8_SA(b, h) + aoff + m * 2048 + k * 1024); } while (0)
#define PG8_LDB(dst, b, h) do { _Pragma("unroll") for (int n = 0; n < 2; ++n) _Pragma("unroll") for (int k = 0; k < 2; ++k) dst[n][k] = *(const PG8_LAS bf16x8*)(lds + PG8_SB(b, h) + boff + n * 2048 + k * 1024); } while (0)
#define PG8_MMA(ai, bj, At, Bt) do { __builtin_amdgcn_s_setprio(1); _Pragma("unroll") for (int m = 0; m < 4; ++m) _Pragma("unroll") for (int n = 0; n < 2; ++n) _Pragma("unroll") for (int k = 0; k < 2; ++k) \
        acc[ai][bj][m][n] = __builtin_amdgcn_mfma_f32_16x16x32_bf16(Bt[n][k], At[m][k], acc[ai][bj][m][n], 0, 0, 0); __builtin_amdgcn_s_setprio(0); } while (0)
#define PG8_WAIT_V(n) asm volatile("s_waitcnt vmcnt(" #n ")" ::: "memory")
#define PG8_WAIT_L(n) asm volatile("s_waitcnt lgkmcnt(" #n ")" ::: "memory")
#define PG8_BAR __builtin_amdgcn_s_barrier()
#define PG8_SCHED __builtin_amdgcn_sched_barrier(0)
    Unit cur, nxt; int ui = 0;
    if (!S.next(0, cur)) return;
    f32x4 acc[2][2][4][2];
#pragma unroll
    for (int a = 0; a < 2; ++a)
#pragma unroll
        for (int b = 0; b < 2; ++b)
#pragma unroll
            for (int m = 0; m < 4; ++m)
#pragma unroll
                for (int n = 0; n < 2; ++n) acc[a][b][m][n] = (f32x4){0.f, 0.f, 0.f, 0.f};
    bf16x8 At[4][2], B0[2][2], B1[2][2];
    const char* cA = (const char*)g.A + (size_t)cur.pm * tstep; const char* cB = (const char*)g.Bt + (size_t)cur.pn * tstep;
    S.a_ready(cur);
    if constexpr (SP2) {
        PG8_STAGE(PG8_SB(0, 0), cB, voffB); PG8_STAGE(PG8_SB(0, 1), cB + hstep, voffB); PG8_STAGE(PG8_SA(0, 0), cA, voffA); PG8_STAGE(PG8_SA(0, 1), cA + hstep, voffA);
        if (wr == 1) PG8_BAR;
        PG8_WAIT_V(2); PG8_BAR;
        PG8_STAGE(PG8_SB(1, 0), cB + kstep, voffB); PG8_STAGE(PG8_SA(1, 0), cA + kstep, voffA); PG8_STAGE(PG8_SB(1, 1), cB + hstep + kstep, voffB);
        PG8_WAIT_V(6); PG8_BAR;
    } else {
        PG8_STAGE(PG8_SB(0, 0), cB, voffB); PG8_STAGE(PG8_SA(0, 0), cA, voffA); PG8_STAGE(PG8_SB(0, 1), cB + hstep, voffB); PG8_STAGE(PG8_SA(0, 1), cA + hstep, voffA);
        if (wr == 1) PG8_BAR;
        PG8_WAIT_V(4); PG8_BAR;
        PG8_STAGE(PG8_SB(1, 0), cB + kstep, voffB); PG8_STAGE(PG8_SA(1, 0), cA + kstep, voffA); PG8_STAGE(PG8_SB(1, 1), cB + hstep + kstep, voffB);
        PG8_WAIT_V(6); PG8_BAR;
    }
    for (;;) {
        const bool has_next = S.next(ui + 1, nxt);
        const char* nA = has_next ? (const char*)g.A + (size_t)nxt.pm * tstep : cA; const char* nB = has_next ? (const char*)g.Bt + (size_t)nxt.pn * tstep : cB;
        for (int t = 0; t < nt; t += 2) {
            const bool last = (t == nt - 2);
            const char* a1 = cA + (size_t)(t + 1) * kstep;
            const char* a2 = last ? nA : cA + (size_t)(t + 2) * kstep; const char* b2 = last ? nB : cB + (size_t)(t + 2) * kstep;
            const char* a3 = a2 + kstep; const char* b3 = b2 + kstep;
            if (last && has_next) S.a_ready(nxt);
            if constexpr (SP2) {
            PG8_LDB(B0, 0, 0); PG8_LDB(B1, 0, 1); PG8_SCHED; PG8_LDA(At, 0, 0); PG8_STAGE(PG8_SA(1, 1), a1 + hstep, voffA);
            PG8_WAIT_V(8); PG8_WAIT_L(0); PG8_BAR; PG8_MMA(0, 0, At, B0); PG8_MMA(0, 1, At, B1); PG8_BAR; PG8_SCHED;
            PG8_LDA(At, 0, 1); PG8_STAGE(PG8_SB(0, 0), b2, voffB); PG8_STAGE(PG8_SB(0, 1), b2 + hstep, voffB); PG8_STAGE(PG8_SA(0, 0), a2, voffA);
            PG8_WAIT_V(8); PG8_WAIT_L(0); PG8_BAR; PG8_MMA(1, 0, At, B0); PG8_MMA(1, 1, At, B1); PG8_BAR; PG8_SCHED;
            PG8_LDB(B0, 1, 0); PG8_LDB(B1, 1, 1); PG8_SCHED; PG8_LDA(At, 1, 0); PG8_STAGE(PG8_SA(0, 1), a2 + hstep, voffA);
            PG8_WAIT_V(8); PG8_WAIT_L(0); PG8_BAR; PG8_MMA(0, 0, At, B0); PG8_MMA(0, 1, At, B1); PG8_BAR; PG8_SCHED;
            PG8_LDA(At, 1, 1); PG8_STAGE(PG8_SB(1, 0), b3, voffB); PG8_STAGE(PG8_SB(1, 1), b3 + hstep, voffB); PG8_STAGE(PG8_SA(1, 0), a3, voffA);
            PG8_WAIT_V(8); PG8_WAIT_L(0); PG8_BAR; PG8_MMA(1, 0, At, B0); PG8_MMA(1, 1, At, B1); PG8_BAR; PG8_SCHED;
            } else {
            PG8_LDB(B0, 0, 0); PG8_SCHED; PG8_LDA(At, 0, 0); PG8_STAGE(PG8_SA(1, 1), a1 + hstep, voffA);
            PG8_WAIT_L(8); PG8_BAR; PG8_WAIT_L(0); PG8_MMA(0, 0, At, B0); PG8_BAR; PG8_SCHED;
            PG8_LDB(B1, 0, 1); PG8_STAGE(PG8_SB(0, 0), b2, voffB);
            PG8_BAR; PG8_WAIT_L(0); PG8_MMA(0, 1, At, B1); PG8_BAR;
            PG8_LDA(At, 0, 1); PG8_STAGE(PG8_SA(0, 0), a2, voffA);
            PG8_BAR; PG8_WAIT_L(0); PG8_MMA(1, 0, At, B0); PG8_BAR; PG8_SCHED;
            PG8_STAGE(PG8_SB(0, 1), b2 + hstep, voffB);
            PG8_WAIT_V(6); PG8_BAR; PG8_MMA(1, 1, At, B1); PG8_BAR;
            PG8_LDB(B0, 1, 0); PG8_SCHED; PG8_LDA(At, 1, 0); PG8_STAGE(PG8_SA(0, 1), a2 + hstep, voffA);
            PG8_WAIT_L(8); PG8_BAR; PG8_WAIT_L(0); PG8_MMA(0, 0, At, B0); PG8_BAR; PG8_SCHED;
            PG8_LDB(B1, 1, 1); PG8_STAGE(PG8_SB(1, 0), b3, voffB);
            PG8_BAR; PG8_WAIT_L(0); PG8_MMA(0, 1, At, B1); PG8_BAR;
            PG8_LDA(At, 1, 1); PG8_STAGE(PG8_SA(1, 0), a3, voffA);
            PG8_BAR; PG8_WAIT_L(0); PG8_MMA(1, 0, At, B0); PG8_BAR; PG8_SCHED;
            PG8_STAGE(PG8_SB(1, 1), b3 + hstep, voffB);
            PG8_WAIT_V(6); PG8_BAR; PG8_MMA(1, 1, At, B1); PG8_BAR;
            }
        }
        if constexpr (ALIGN_EPI) { if (wr == 0) PG8_BAR; }
        if constexpr (!Epi::AFTER_DRAIN) { E(acc, cur, wr, wc, fr, fq); S.done(cur); }
        if (!has_next) break;
#pragma unroll
        for (int a = 0; a < 2; ++a)
#pragma unroll
            for (int b = 0; b < 2; ++b)
#pragma unroll
                for (int m = 0; m < 4; ++m)
#pragma unroll
                    for (int n = 0; n < 2; ++n) acc[a][b][m][n] = (f32x4){0.f, 0.f, 0.f, 0.f};
        cur = nxt; cA = nA; cB = nB; ++ui;
        if constexpr (ALIGN_EPI) { if (wr == 1) PG8_BAR; }
    }
    PG8_WAIT_V(0);
    if constexpr (!ALIGN_EPI) { if (wr == 0) PG8_BAR; }
    PG8_BAR;
    if constexpr (Epi::AFTER_DRAIN) { E.fused(acc, cur, wr, wc, fr, fq, lds, wid, lane); S.done(cur); }
#undef PG8_SA
#undef PG8_SB
#undef PG8_STAGE
#undef PG8_LDA
#undef PG8_LDB
#undef PG8_MMA
#undef PG8_WAIT_V
#undef PG8_WAIT_L
#undef PG8_BAR
#undef PG8_SCHED
}

}
namespace att {
constexpr int D = 128;
constexpr float SCALE = 0.08838834764831845f;
constexpr float THR = 8.f;
constexpr int NW = 8, QBLK = 32, KVBLK = 64, QB = NW * QBLK;
constexpr int SHM_V = KVBLK * D * 2, SHM_K = KVBLK * D * 2;
constexpr int ATT_LDS = 2 * SHM_V + 2 * SHM_K + NW * 64 * 4;
#define KSWZ(row, colB) ((row) * 256 + ((colB) ^ (((row) & 7) << 4)))
#define SBAR() __builtin_amdgcn_sched_barrier(0)
__device__ __forceinline__ int v_st(int k, int c) { const int kk = (k & ~0xC) | ((k & 4) << 1) | ((k & 8) >> 1); return ((kk >> 3) * 4 + (c >> 5)) * 512 + ((kk & 7) * 32 + (c & 31)) * 2; }
__device__ __forceinline__ int v_rd_base(int lane) { return ((lane & 3) << 3) | (((lane >> 2) & 3) << 6) | (((lane >> 4) & 1) << 5) | (((lane >> 5) & 1) << 8); }
constexpr int v_rd_off(int d0, int ks, int half) { return d0 * 512 + ks * 4096 + half * 2048; }
__device__ __forceinline__ int crow(int r, int hi) { return (r & 3) + 8 * (r >> 2) + 4 * hi; }
__device__ __forceinline__ unsigned cvtpk(float lo, float hi) { unsigned r; asm volatile("v_cvt_pk_bf16_f32 %0, %1, %2" : "=v"(r) : "v"(lo), "v"(hi)); return r; }
__device__ __forceinline__ bf16x8 ld8(const bf16_t* p) { return *reinterpret_cast<const bf16x8*>(p); }
__device__ __forceinline__ void mask_causal(f32x16& p0, f32x16& p1, int dq) {
    const float NEG = -__builtin_inff();
#pragma unroll
    for (int r = 0; r < 16; ++r) {
        const int c = (r & 3) + 8 * (r >> 2);
        if (dq - c < 0) p0[r] = NEG;
        if (dq - c - 32 < 0) p1[r] = NEG;
    }
}
__device__ __forceinline__ void mask_all(f32x16& p0, f32x16& p1, bool keep) {
    const float NEG = -__builtin_inff();
#pragma unroll
    for (int r = 0; r < 16; ++r) { p0[r] = keep ? p0[r] : NEG; p1[r] = keep ? p1[r] : NEG; }
}
__device__ __forceinline__ void partialSM(f32x16& p0, f32x16& p1, float& m_reg, float& mn, float& alpha) {
    float pmax = p0[0];
#pragma unroll
    for (int r = 1; r < 16; ++r) pmax = fmaxf(pmax, p0[r]);
#pragma unroll
    for (int r = 0; r < 16; ++r) pmax = fmaxf(pmax, p1[r]);
    { auto rr = __builtin_amdgcn_permlane32_swap(__float_as_uint(pmax), __float_as_uint(pmax), false, false);
      pmax = fmaxf(__uint_as_float(rr[0]), __uint_as_float(rr[1])); }
    constexpr float C2 = 1.4426950408889634f * SCALE;
    if (__builtin_expect(__all((pmax - m_reg) * SCALE <= THR), 1)) { mn = m_reg; alpha = 1.f; }
    else { mn = fmaxf(m_reg, pmax); alpha = __builtin_amdgcn_exp2f((m_reg - mn) * C2); m_reg = mn; }
    const float mnL = -mn * C2;
#pragma unroll
    for (int r = 0; r < 16; ++r) p0[r] = fmaf(p0[r], C2, mnL);
#pragma unroll
    for (int r = 0; r < 16; ++r) p1[r] = fmaf(p1[r], C2, mnL);
#pragma unroll
    for (int r = 0; r < 16; ++r) p0[r] = __builtin_amdgcn_exp2f(p0[r]);
}
__device__ __forceinline__ void finishSM(f32x16& p0, f32x16& p1, float alpha, float& l_reg, bf16x8& pa0, bf16x8& pa1, bf16x8& pa2, bf16x8& pa3) {
#pragma unroll
    for (int r = 0; r < 16; ++r) p1[r] = __builtin_amdgcn_exp2f(p1[r]);
    float ps = 0;
#pragma unroll
    for (int r = 0; r < 16; ++r) ps += p0[r];
#pragma unroll
    for (int r = 0; r < 16; ++r) ps += p1[r];
    { auto rr = __builtin_amdgcn_permlane32_swap(__float_as_uint(ps), __float_as_uint(ps), false, false);
      ps = __uint_as_float(rr[0]) + __uint_as_float(rr[1]); }
    l_reg = l_reg * alpha + ps;
#define PK4(P, B_, OUT) do { unsigned a0 = cvtpk(P[B_+0], P[B_+1]), a1 = cvtpk(P[B_+2], P[B_+3]);                          \
        unsigned b0 = cvtpk(P[B_+4], P[B_+5]), b1 = cvtpk(P[B_+6], P[B_+7]);                                             \
        auto r0 = __builtin_amdgcn_permlane32_swap(a0, b0, false, false); auto r1 = __builtin_amdgcn_permlane32_swap(a1, b1, false, false); \
        u32x4 w = {r0[0], r1[0], r0[1], r1[1]}; OUT = *reinterpret_cast<bf16x8*>(&w); } while (0)
    PK4(p0, 0, pa0); PK4(p0, 8, pa1); PK4(p1, 0, pa2); PK4(p1, 8, pa3);
#undef PK4
}
template <int KB>
__device__ __forceinline__ void qkt(f32x16& p0, f32x16& p1, const char* K_lds, int r32, int hi, const bf16x8* qr) {
    p0 = f32x16{}; p1 = f32x16{};
    const char* kb[4];
#pragma unroll
    for (int dd = 0; dd < 4; ++dd) kb[dd] = K_lds + KB * SHM_K + KSWZ(r32, (dd * 16 + hi * 8) * 2);
#pragma unroll
    for (int d0 = 0; d0 < 8; ++d0) { const char* a = kb[d0 & 3] + (d0 >> 2) * 128;
        bf16x8 b0 = *reinterpret_cast<const bf16x8*>(a);
        bf16x8 b1 = *reinterpret_cast<const bf16x8*>(a + 32 * 256);
        p0 = __builtin_amdgcn_mfma_f32_32x32x16_bf16(b0, qr[d0], p0, 0, 0, 0);
        p1 = __builtin_amdgcn_mfma_f32_32x32x16_bf16(b1, qr[d0], p1, 0, 0, 0); }
}
template <int VB>
__device__ __forceinline__ void pv_tile(f32x16* o, int vb0, bf16x8 pa0, bf16x8 pa1, bf16x8 pa2, bf16x8 pa3) {
#define TRRD(dst, off) asm volatile("ds_read_b64_tr_b16 %0, %1 offset:%2" : "=&v"(dst) : "v"(vb0), "i"(off) : "memory")
#define PV_D0(d0) do { s16x4 l0, l1, l2, l3, h0, h1, h2, h3; constexpr int b_ = VB * SHM_V + v_rd_off(d0, 0, 0);     \
        TRRD(l0, b_); TRRD(h0, b_ + 2048); TRRD(l1, b_ + 4096); TRRD(h1, b_ + 6144); TRRD(l2, b_ + 8192); TRRD(h2, b_ + 10240); TRRD(l3, b_ + 12288); TRRD(h3, b_ + 14336); \
        asm volatile("s_waitcnt lgkmcnt(0)" ::: "memory"); SBAR();                                                                \
        o[d0] = __builtin_amdgcn_mfma_f32_32x32x16_bf16(pa0, (bf16x8){l0[0], l0[1], l0[2], l0[3], h0[0], h0[1], h0[2], h0[3]}, o[d0], 0, 0, 0);   \
        o[d0] = __builtin_amdgcn_mfma_f32_32x32x16_bf16(pa1, (bf16x8){l1[0], l1[1], l1[2], l1[3], h1[0], h1[1], h1[2], h1[3]}, o[d0], 0, 0, 0);   \
        o[d0] = __builtin_amdgcn_mfma_f32_32x32x16_bf16(pa2, (bf16x8){l2[0], l2[1], l2[2], l2[3], h2[0], h2[1], h2[2], h2[3]}, o[d0], 0, 0, 0);   \
        o[d0] = __builtin_amdgcn_mfma_f32_32x32x16_bf16(pa3, (bf16x8){l3[0], l3[1], l3[2], l3[3], h3[0], h3[1], h3[2], h3[3]}, o[d0], 0, 0, 0); } while (0)
    PV_D0(0); PV_D0(1); PV_D0(2); PV_D0(3);
#undef PV_D0
#undef TRRD
}
constexpr int LDZ = ZLD, LDO = 1024;
#define ROW(p, k0, rr) ((p) + (size_t)((k0) + (rr)) * LDZ + sc)
#define VMW() asm volatile("s_waitcnt vmcnt(0)" ::: "memory")
#define SLOAD_H(Kp, Vp, k0) do { st_v0 = ld8(ROW(Vp, k0, sr)); st_v1 = ld8(ROW(Vp, k0, 32 + sr));              \
                         st_k0 = ld8(ROW(Kp, k0, sr)); st_k1 = ld8(ROW(Kp, k0, 32 + sr)); } while (0)
#define SWRITE_H(bf) do { *(bf16x8*)(V_lds + (bf) * SHM_V + vst0) = st_v0; *(bf16x8*)(V_lds + (bf) * SHM_V + vst1) = st_v1;      \
                          *(bf16x8*)(K_lds + (bf) * SHM_K + kws) = st_k0; *(bf16x8*)(K_lds + (bf) * SHM_K + kws + 32 * 256) = st_k1; } while (0)
template <bool CAUSAL>
__device__ __forceinline__ void moba_core(const bf16_t* qrow, const bf16_t* Kh, const bf16_t* Vh, int kb0, char* lds, int tid, f32x16 (&o)[4], float& m_reg, float& l_reg) {
    const int wid = __builtin_amdgcn_readfirstlane(tid >> 6), lane = tid & 63, r32 = lane & 31, hi = lane >> 5;
    constexpr int NT = 4;
    const int qlo = wid * QBLK, qm = qlo + r32 - 4 * hi;
    char* V_lds = lds; char* K_lds = lds + 2 * SHM_V;
    float* ws = (float*)(lds + 2 * SHM_V + 2 * SHM_K) + wid * 64; float* al_l = ws + 32;
    m_reg = -1e30f; l_reg = 0;
#pragma unroll
    for (int d = 0; d < 4; ++d) o[d] = f32x16{};
    const int sr = tid >> 4, sc = (tid & 15) * 8, vst0 = v_st(sr, sc), vst1 = v_st(32 + sr, sc), kws = KSWZ(sr, sc * 2);
    const int vb0 = (int)(uintptr_t)V_lds + v_rd_base(lane);
    bf16x8 qr[8], st_v0, st_v1, st_k0, st_k1;
#pragma unroll
    for (int d0 = 0; d0 < 8; ++d0) qr[d0] = ld8(qrow + d0 * 16 + hi * 8);
    SLOAD_H(Kh, Vh, kb0); VMW(); SWRITE_H(0);
    __syncthreads();
#define RESC(a) do { if (__any((a) < 1.f)) { if (hi == 0) al_l[r32] = (a); asm volatile("s_waitcnt lgkmcnt(0)" ::: "memory");              \
                     for (int d_ = 0; d_ < 4; ++d_) for (int r = 0; r < 16; ++r) o[d_][r] *= al_l[crow(r, hi)]; } } while (0)
#define TILE_STEP(t, BUF) do { f32x16 p0, p1; float mn, al; bf16x8 pa0, pa1, pa2, pa3;                                         \
        if ((t) + 1 < NT) { SLOAD_H(Kh, Vh, kb0 + ((t) + 1) * KVBLK); } SBAR();                                                   \
        qkt<BUF>(p0, p1, K_lds, r32, hi, qr);                                                                                   \
        if (CAUSAL) { if ((t) * KVBLK + KVBLK - 1 > qlo) mask_causal(p0, p1, qm - (t) * KVBLK); }                               \
        partialSM(p0, p1, m_reg, mn, al); RESC(al); finishSM(p0, p1, al, l_reg, pa0, pa1, pa2, pa3); SBAR();                    \
        pv_tile<BUF>(o, vb0, pa0, pa1, pa2, pa3); SBAR();                                                                      \
        if ((t) + 1 < NT) { VMW(); SWRITE_H(1 - BUF); }                                                                        \
        __syncthreads(); } while (0)
    TILE_STEP(0, 0); TILE_STEP(1, 1); TILE_STEP(2, 0); TILE_STEP(3, 1);
#undef RESC
#undef TILE_STEP
}
__device__ __forceinline__ void moba_past_tile(const bf16_t* Zb  , int h, int j, const unsigned* list, int cnt, int e0, bf16_t* PARTbh, float* MLbh, char* lds) {
    int tid = threadIdx.x; asm volatile("" : "+v"(tid));
    const int wid = __builtin_amdgcn_readfirstlane(tid >> 6), lane = tid & 63, r32 = lane & 31;
    const int e = e0 + wid * QBLK + r32; const bool valid = e < cnt;
    const unsigned ent = list[valid ? e : 0];
    const bf16_t* qrow = Zb + (size_t)(ent & 0xffffu) * LDZ + ZC_Q + h * 128;
    f32x16 o[4]; float m_reg, l_reg;
    moba_core<false>(qrow, Zb + ZC_KB + h * 128, Zb + ZC_VB + h * 128, j * 256, lds, tid, o, m_reg, l_reg);
    int lane_e = lane; asm volatile("" : "+v"(lane_e));
    const int r32e = lane_e & 31, hie = lane_e >> 5;
    float* ws = (float*)(lds + 2 * SHM_V + 2 * SHM_K) + wid * 64; float* li_l = ws; unsigned* en_l = (unsigned*)(ws + 32);
    if (hie == 0) { li_l[r32e] = l_reg; en_l[r32e] = valid ? ent : 0xffffffffu;
        if (valid) *(f32x2*)(MLbh + ((size_t)(ent & 0xffffu) * 3 + (ent >> 16)) * 2) = (f32x2){m_reg, l_reg}; }
    asm volatile("s_waitcnt lgkmcnt(0)" ::: "memory");
#pragma unroll
    for (int r = 0; r < 16; ++r) { const int orow = crow(r, hie); const float rl = __builtin_amdgcn_rcpf(li_l[orow]); const unsigned en = en_l[orow];
        bf16_t* dst = PARTbh + ((size_t)(en & 0xffffu) * 3 + (en >> 16)) * 128;
#pragma unroll
        for (int d0 = 0; d0 < 4; ++d0) { const float v = o[d0][r] * rl; const float vn = __shfl_xor(v, 1);
            if ((r32e & 1) == 0 && en != 0xffffffffu) *(unsigned*)(dst + d0 * 32 + r32e) = cvtpk(v, vn); } }
    asm volatile("s_waitcnt lgkmcnt(0)" ::: "memory");
    __syncthreads();
}
__device__ __forceinline__ void moba_own_unit(const bf16_t* Zb, int h, int qb, int nsel, const bf16_t* PARTbh, const float* MLbh, bf16_t* Ob  , char* lds) {
    int tid = threadIdx.x; asm volatile("" : "+v"(tid));
    const int wid = __builtin_amdgcn_readfirstlane(tid >> 6), lane = tid & 63, r32 = lane & 31;
    const int t = qb * 256 + wid * QBLK + r32;
    f32x16 o[4]; float m_reg, l_reg;
    moba_core<true>(Zb + (size_t)t * LDZ + ZC_Q + h * 128, Zb + ZC_KB + h * 128, Zb + ZC_VB + h * 128, qb * 256, lds, tid, o, m_reg, l_reg);
    int lane_e = lane; asm volatile("" : "+v"(lane_e));
    const int r32e = lane_e & 31, hie = lane_e >> 5, te = qb * 256 + wid * QBLK + r32e;
    float* ws = (float*)(lds + 2 * SHM_V + 2 * SHM_K) + wid * 64; float* f_l = ws;
    float* fl = (float*)(lds + 2 * SHM_V + 2 * SHM_K + NW * 64 * 4) + wid * 128;
    constexpr float C2 = 1.4426950408889634f * SCALE;
    float ms[3], ls[3]; float M = m_reg;
#pragma unroll
    for (int s = 0; s < 3; ++s) { ms[s] = -1e30f; ls[s] = 0.f; if (s < nsel) { const f32x2 ml = *(const f32x2*)(MLbh + ((size_t)te * 3 + s) * 2); ms[s] = ml.x; ls[s] = ml.y; M = fmaxf(M, ml.x); } }
    const float wo = l_reg * __builtin_amdgcn_exp2f((m_reg - M) * C2);
    float w[3], W = wo;
#pragma unroll
    for (int s = 0; s < 3; ++s) { w[s] = ls[s] * __builtin_amdgcn_exp2f((ms[s] - M) * C2); W += w[s]; }
    const float rW = __builtin_amdgcn_rcpf(W);
    if (hie == 0) { fl[r32e] = __builtin_amdgcn_exp2f((m_reg - M) * C2) * rW;
#pragma unroll
        for (int s = 0; s < 3; ++s) fl[(s + 1) * 32 + r32e] = w[s] * rW; }
    asm volatile("s_waitcnt lgkmcnt(0)" ::: "memory");
    (void)f_l;
#pragma unroll
    for (int r = 0; r < 16; ++r) { const float f = fl[crow(r, hie)];
#pragma unroll
        for (int d0 = 0; d0 < 4; ++d0) o[d0][r] *= f; }
    bf16_t* gl = (bf16_t*)(lds + wid * 8192);
    for (int s = 0; s < nsel; ++s) {
        { const bf16_t* src = PARTbh + ((size_t)(qb * 256 + wid * QBLK) * 3 + s) * 128; const int lane2 = lane_e;
#pragma unroll
          for (int i = 0; i < 8; ++i) { const int rr = i * 4 + (lane2 >> 4), ch = lane2 & 15; *(bf16x8*)(gl + rr * 128 + ch * 8) = ld8(src + (size_t)rr * 384 + ch * 8); } }
        asm volatile("s_waitcnt vmcnt(0) lgkmcnt(0)" ::: "memory");
#pragma unroll
        for (int r = 0; r < 16; ++r) { const int orow = crow(r, hie); const float f = fl[(s + 1) * 32 + orow];
#pragma unroll
            for (int d0 = 0; d0 < 4; ++d0) o[d0][r] += f * bf2f(gl[orow * 128 + d0 * 32 + r32e]); }
        asm volatile("s_waitcnt lgkmcnt(0)" ::: "memory");
    }
    { const bf16_t* Gw = Zb + (size_t)(qb * 256 + wid * QBLK) * LDZ + ZC_GB + h * 128; const int lane2 = lane_e;
#pragma unroll
      for (int i = 0; i < 8; ++i) { const int rr = i * 4 + (lane2 >> 4), ch = lane2 & 15; *(bf16x8*)(gl + rr * 128 + ch * 8) = ld8(Gw + (size_t)rr * LDZ + ch * 8); } }
    asm volatile("s_waitcnt vmcnt(0) lgkmcnt(0)" ::: "memory");
    bf16_t* Ow = Ob + (size_t)(qb * 256 + wid * QBLK) * LDO;
#pragma unroll
    for (int r = 0; r < 16; ++r) { const int orow = crow(r, hie);
#pragma unroll
        for (int d0 = 0; d0 < 4; ++d0) { const float v = o[d0][r] * bf2f(gl[orow * 128 + d0 * 32 + r32e]); const float vn = __shfl_xor(v, 1);
            if ((r32e & 1) == 0) *(unsigned*)(Ow + (size_t)orow * LDO + d0 * 32 + r32e) = cvtpk(v, vn); } }
    asm volatile("s_waitcnt lgkmcnt(0)" ::: "memory");
    __syncthreads();
}
#undef ROW
#undef VMW
#undef SLOAD_H
#undef SWRITE_H
}
constexpr size_t MiB = 1u << 20;
constexpr size_t WS_CTL = 0, CTL_ZERO_BYTES = 1 * MiB;
constexpr size_t WS_WINT = 2 * MiB;
constexpr size_t WS_PAT = 52 * MiB, WS_PBT = 56 * MiB, WS_WOT = 60 * MiB;
constexpr size_t WS_XN = 68 * MiB;
constexpr size_t WS_XS = 100 * MiB;
constexpr size_t WS_ROPE = 101 * MiB;
constexpr size_t WS_ZS = 102 * MiB;
constexpr size_t WS_KMP = 103 * MiB;
constexpr size_t WS_Z = 104 * MiB;
constexpr size_t WS_OA = 300 * MiB, WS_OB = 317 * MiB;
constexpr size_t WS_MRG = 334 * MiB;
constexpr size_t WS_TMP = 367 * MiB;
constexpr size_t WS_KMS = 644 * MiB;
constexpr size_t WS_CPM = 448 * MiB, WS_CQ = 464 * MiB, WS_CYQ = 496 * MiB, WS_CYL = 512 * MiB, WS_CBV = 544 * MiB, WS_CSG = 560 * MiB, WS_CSC = 576 * MiB;
constexpr size_t WS_LST = 436 * MiB;
constexpr size_t WS_PART = 592 * MiB, WS_ML = 640 * MiB;
constexpr size_t WS_END = 660 * MiB;
constexpr int CW_BAR = 4096;
constexpr int CW_CNT = 12288;
constexpr int CW_QKM = 8192;

constexpr int RING_BYTES = 131072, LDS_BYTES = 147456, LDSCTL_OFF = LDS_BYTES - 1024, MISC_OFF = LDSCTL_OFF + 320;
constexpr int NWAVES = 8, NTHR = 512;

#define XB_TMO      128
#define XB_XCNT(j)  (256  + 64 * (j))
#define XB_XSUB(j)  (1280 + 64 * (j))
#define XB_XGEN(j)  (2304 + 64 * (j))
#define XB_TOP      3328
#define XB_TOPGEN   3392
#define XCD_BAR_WORDS 3456
#define XB_SPIN_CAP (1u << 18)
__device__ __forceinline__ unsigned xb_ld(unsigned* p)              { return __hip_atomic_load(p, __ATOMIC_RELAXED, __HIP_MEMORY_SCOPE_AGENT); }
__device__ __forceinline__ unsigned xb_add(unsigned* p, unsigned v) { return __hip_atomic_fetch_add(p, v, __ATOMIC_RELAXED, __HIP_MEMORY_SCOPE_AGENT); }
__device__ __forceinline__ unsigned xb_xcc_id() { return (unsigned)__builtin_amdgcn_s_getreg((3 << 11) | 20) & 0xFu; }
#define XB_SPIN(cond, bar) do { unsigned _sp = 0; while (cond) { __builtin_amdgcn_s_sleep(1); \
    if ((++_sp & 255u) == 0u) { if (xb_ld(&(bar)[XB_TMO])) break; if (_sp > XB_SPIN_CAP) { atomicAdd(&(bar)[XB_TMO], 1u); break; } } } } while (0)
struct XcdBarrier { unsigned* bar; unsigned x; volatile LAS unsigned* st; };
__device__ __forceinline__ XcdBarrier xcd_barrier_post(unsigned* bar, volatile LAS unsigned* st) {
    XcdBarrier b; b.bar = bar; b.x = xb_xcc_id(); b.st = st;
    if (threadIdx.x == 0) (void)xb_add(&bar[XB_XCNT(b.x)], 1u);
    return b;
}
__device__ __forceinline__ void xcd_barrier_complete(unsigned* bar, unsigned x, unsigned& nloc, unsigned& nx) {
    const unsigned G = gridDim.x * gridDim.y * gridDim.z;
    unsigned sum, cnt, mine, sp = 0u;
    for (;;) {
        sum = 0u; cnt = 0u; mine = 0u;
#pragma unroll
        for (unsigned j = 0; j < 16; ++j) { const unsigned c = xb_ld(&bar[XB_XCNT(j)]); sum += c; cnt += (c > 0u) ? 1u : 0u; mine = (j == x) ? c : mine; }
        if (sum == G) break;
        __builtin_amdgcn_s_sleep(1);
        if ((++sp & 255u) == 0u) { if (xb_ld(&bar[XB_TMO])) break; if (sp > XB_SPIN_CAP) { atomicAdd(&bar[XB_TMO], 1u); break; } }
    }
    nloc = mine > 0u ? mine : 1u; nx = cnt > 0u ? cnt : 1u;
}
__device__ __forceinline__ void xcd_barrier(const XcdBarrier& b) {
    asm volatile("s_waitcnt vmcnt(0)" ::: "memory");
    __syncthreads();
    if (threadIdx.x == 0) {
        unsigned* bar = b.bar;
        __builtin_amdgcn_s_waitcnt(0);
        unsigned nloc = b.st[0], nx = b.st[1];
        if (nloc == 0u) { xcd_barrier_complete(bar, b.x, nloc, nx); b.st[0] = nloc; b.st[1] = nx; }
        const unsigned old = xb_add(&bar[XB_XSUB(b.x)], 1u);
        const unsigned gen = old / nloc;
        if (old + 1u == (gen + 1u) * nloc) {
            __builtin_amdgcn_fence(__ATOMIC_RELEASE, "agent");
            asm volatile("s_waitcnt vmcnt(0)" ::: "memory");
            const unsigned og = xb_add(&bar[XB_TOP], 1u);
            const unsigned tg = og / nx;
            if (og + 1u == (tg + 1u) * nx) xb_add(&bar[XB_TOPGEN], 1u);
            else XB_SPIN(xb_ld(&bar[XB_TOPGEN]) == tg, bar);
            __builtin_amdgcn_fence(__ATOMIC_ACQUIRE, "agent");
            xb_add(&bar[XB_XGEN(b.x)], 1u);
            asm volatile("s_waitcnt vmcnt(0)" ::: "memory");
        } else {
            XB_SPIN(xb_ld(&bar[XB_XGEN(b.x)]) == gen, bar);
            __builtin_amdgcn_fence(__ATOMIC_ACQUIRE, "agent");
            asm volatile("s_waitcnt vmcnt(0)" ::: "memory");
        }
    }
    __syncthreads();
}

struct Args { const void* in[23]; float* out; unsigned char* ws; int ph_lo, ph_hi; };
struct Frame {
    LAS unsigned char* lds; char* ldsg;
    int tid, lane, wave, G, bid;
    const float *x_p, *x_s, *st_shift, *st_wkv, *cache_k, *cache_v; const int* page_table;
    const float *ln_w, *w_in, *mu, *w0, *w2, *a0, *a2, *k_k, *k_a, *r_k, *lnx_w, *lnx_b, *p_a, *p_b, *w_o, *final_w;
    float* out; unsigned char* ws;
};

__device__ __forceinline__ void p0_transpose_item(const float* W, int K, int N, bf16_t* WT, int dst_n0, int src_n0, int k0, LAS float* scr, int lane, bool perm) {
    if (src_n0 >= 0) {
#pragma unroll 8
        for (int i = 0; i < 32; ++i) { const int kk = 2 * i + (lane >> 5); scr[kk * 33 + (lane & 31)] = W[(size_t)(k0 + kk) * N + src_n0 + (lane & 31)]; }
    } else {
#pragma unroll 8
        for (int i = 0; i < 32; ++i) { const int kk = 2 * i + (lane >> 5); scr[kk * 33 + (lane & 31)] = 0.f; }
    }
    LDS_WAIT(); asm volatile("" ::: "memory");
    const int c = lane & 7;
#pragma unroll
    for (int j = 0; j < 4; ++j) { const int n = (lane >> 3) + 8 * j; const LAS float* s = scr + (8 * c) * 33 + n;
        u32x4 o; o.x = cvt_pk_bf16(s[0 * 33], s[1 * 33]); o.y = cvt_pk_bf16(s[2 * 33], s[3 * 33]); o.z = cvt_pk_bf16(s[4 * 33], s[5 * 33]); o.w = cvt_pk_bf16(s[6 * 33], s[7 * 33]);
        *(u32x4*)(WT + (size_t)(perm ? wrow(dst_n0 + n) : dst_n0 + n) * K + k0 + 8 * c) = o; }
    LDS_WAIT(); asm volatile("" ::: "memory");
}
__device__ __forceinline__ void rms_row(const float* xrow, const float* w, bf16_t* orow, float* frow, int lane) {
    const f32x4* xr = (const f32x4*)xrow + lane; const f32x4* wr = (const f32x4*)w + lane;
    f32x4 v[8]; float s = 0.f;
#pragma unroll
    for (int j = 0; j < 8; ++j) { v[j] = xr[64 * j]; s += (v[j].x * v[j].x + v[j].y * v[j].y) + (v[j].z * v[j].z + v[j].w * v[j].w); }
    const float rstd = 1.0f / sqrtf(wave_sum(s) * (1.f / DM) + NORM_EPS);
#pragma unroll
    for (int j = 0; j < 8; ++j) { const f32x4 y = v[j] * rstd * wr[64 * j];
        u32x2 o; o.x = cvt_pk_bf16(y.x, y.y); o.y = cvt_pk_bf16(y.z, y.w);
        *((u32x2*)orow + lane + 64 * j) = o;
        if (frow) *((f32x4*)frow + lane + 64 * j) = y; }
}
__device__ __forceinline__ void phase_prologue(Frame& F) {
    LAS float* scr = (LAS float*)(F.lds + F.wave * 16384);
    const int gw = F.bid * NWAVES + F.wave, NGW = F.G * NWAVES;
    bf16_t* WinT = (bf16_t*)(F.ws + WS_WINT); bf16_t* PaT = (bf16_t*)(F.ws + WS_PAT); bf16_t* PbT = (bf16_t*)(F.ws + WS_PBT); bf16_t* WoT = (bf16_t*)(F.ws + WS_WOT);
    constexpr int I_IN = 32 * (ZLD / 32), I_P = 16 * 64, I_O = 32 * 64, NITEMS = I_IN + 2 * I_P + I_O;
    for (int it = gw; it < NITEMS; it += NGW) {
        int r = it;
        if (r < I_IN) { const int dg = r % (ZLD / 32), kb = r / (ZLD / 32); p0_transpose_item(F.w_in, DM, NIN, WinT, dg * 32, zcol_to_src(dg * 32), kb * 64, scr, F.lane, dg * 32 < ZC_WLO); continue; } r -= I_IN;
        if (r < I_P) { const int dg = r % 64, kb = r / 64; p0_transpose_item(F.p_a, DA, DM, PaT, dg * 32, dg * 32, kb * 64, scr, F.lane, true); continue; } r -= I_P;
        if (r < I_P) { const int dg = r % 64, kb = r / 64; p0_transpose_item(F.p_b, DBB, DM, PbT, dg * 32, dg * 32, kb * 64, scr, F.lane, true); continue; } r -= I_P;
        { const int dg = r % 64, kb = r / 64; p0_transpose_item(F.w_o, DM, DM, WoT, dg * 32, dg * 32, kb * 64, scr, F.lane, true); }
    }
    bf16_t* XN = (bf16_t*)(F.ws + WS_XN); bf16_t* XS = (bf16_t*)(F.ws + WS_XS);
    for (int m = gw; m < MP + 16; m += NGW) {
        if (m < MP) { const bool last = (m & (TSEQ - 1)) == TSEQ - 1; rms_row(F.x_p + (size_t)m * DM, F.ln_w, XN + (size_t)m * DM, last ? F.out + O_SHP + (size_t)(m / TSEQ) * DM : nullptr, F.lane); }
        else if (m < MP + 8) { const int b = m - MP; rms_row(F.x_s + (size_t)b * DM, F.ln_w, XS + (size_t)b * DM, F.out + O_SHS + (size_t)b * DM, F.lane); }
        else { const int b = m - MP - 8; const f32x4* sr = (const f32x4*)(F.st_shift + (size_t)b * DM) + F.lane;
#pragma unroll
            for (int j = 0; j < 8; ++j) { const f32x4 y = sr[64 * j]; u32x2 o; o.x = cvt_pk_bf16(y.x, y.y); o.y = cvt_pk_bf16(y.z, y.w); *((u32x2*)(XS + (size_t)(8 + b) * DM) + F.lane + 64 * j) = o; } }
    }
    float* rope = (float*)(F.ws + WS_ROPE);
    for (int i = F.bid * NTHR + F.tid; i < 4097 * 16; i += F.G * NTHR) {
        const int p = i >> 4, k = i & 15; const double pos = (p < 4096) ? (double)p : (double)PAST;
        const float inv = powf(500000.0f, -(float)k * (2.0f / 32.0f));
        const float ang = (float)pos * inv;
        rope[p * 32 + k] = (float)cos((double)ang); rope[p * 32 + 16 + k] = (float)sin((double)ang);
    }
    { bf16_t* OA = (bf16_t*)(F.ws + WS_OA) + (size_t)(MP + 8) * 1024; bf16_t* OB = (bf16_t*)(F.ws + WS_OB) + (size_t)(MP + 8) * 1024; bf16_t* MG = (bf16_t*)(F.ws + WS_MRG) + (size_t)(MP + 8) * DM;
      for (int i = F.bid * NTHR + F.tid; i < 8 * 1024; i += F.G * NTHR) { OA[i] = 0; OB[i] = 0; MG[i] = 0; MG[i + 8 * 1024] = 0; } }
}

template <int K>
__device__ __forceinline__ f32x4 skinny_tile(const LAS bf16_t* As, int lda, const bf16_t* WT, int n0, int lane) {
    const int r = lane & 15, q = lane >> 4;
    const bf16_t* bp = WT + (size_t)wrow_in(n0 + r) * K + q * 8;
    const LAS bf16_t* ap = As + r * lda + q * 8;
    f32x4 acc = {0.f, 0.f, 0.f, 0.f};
#pragma unroll 8
    for (int k = 0; k < K; k += 32) {
        const bf16x8 a = *(const LAS bf16x8*)(ap + k);
        const bf16x8 b = *(const bf16x8*)(bp + k);
        acc = __builtin_amdgcn_mfma_f32_16x16x32_bf16(a, b, acc, 0, 0, 0);
    }
    return acc;
}
template <int K>
__device__ __forceinline__ void stage_rows16(const bf16_t* src, LAS bf16_t* dst, int tid) {
    for (int i = tid; i < 16 * K / 8; i += NTHR) { const int r = i / (K / 8), c = i % (K / 8); *(LAS u32x4*)(dst + r * (K + 8) + c * 8) = *(const u32x4*)(src + (size_t)r * K + c * 8); }
}
__device__ __forceinline__ void phase_inproj_sample(Frame& F) {
    LAS bf16_t* As = (LAS bf16_t*)F.lds;
    stage_rows16<DM>((const bf16_t*)(F.ws + WS_XS), As, F.tid);
    LDS_WAIT(); __syncthreads();
    const bf16_t* WinT = (const bf16_t*)(F.ws + WS_WINT); float* ZS = (float*)(F.ws + WS_ZS);
    const int gw = F.bid * NWAVES + F.wave, NGW = F.G * NWAVES;
    for (int tile = gw; tile < ZLD / 16; tile += NGW) {
        const f32x4 acc = skinny_tile<DM>(As, DM + 8, WinT, tile * 16, F.lane);
        const int q = F.lane >> 4, n = tile * 16 + (F.lane & 15);
#pragma unroll
        for (int r = 0; r < 4; ++r) ZS[(size_t)(4 * q + r) * ZLD + n] = acc[r];
    }
    __syncthreads();
}

__device__ __forceinline__ void lora_unit(Frame& F, int unit) {
    LAS bf16_t* As = (LAS bf16_t*)F.lds;
    const bf16_t* src = (const bf16_t*)(F.ws + WS_XN) + (size_t)unit * 32 * DM;
    for (int i = F.tid; i < 32 * DM / 8; i += NTHR) { const int r = i >> 8, c = i & 255; *(LAS u32x4*)(As + r * (DM + 8) + c * 8) = *(const u32x4*)(src + (size_t)r * DM + c * 8); }
    LDS_WAIT(); __syncthreads();
    const int r = F.lane & 15, q = F.lane >> 4, n0 = F.wave * 16;
    const bf16_t* bp = (const bf16_t*)(F.ws + WS_WINT) + (size_t)(ZC_WLO + n0 + r) * DM + q * 8;
    const LAS bf16_t* ap = As + r * (DM + 8) + q * 8;
    f32x4 acc0 = {0.f, 0.f, 0.f, 0.f}, acc1 = acc0;
#pragma unroll 8
    for (int k = 0; k < DM; k += 32) {
        const bf16x8 bfr = *(const bf16x8*)(bp + k);
        const bf16x8 a0 = *(const LAS bf16x8*)(ap + k), a1 = *(const LAS bf16x8*)(ap + 16 * (DM + 8) + k);
        acc0 = __builtin_amdgcn_mfma_f32_16x16x32_bf16(bfr, a0, acc0, 0, 0, 0);
        acc1 = __builtin_amdgcn_mfma_f32_16x16x32_bf16(bfr, a1, acc1, 0, 0, 0);
    }
    bf16_t* Z = (bf16_t*)(F.ws + WS_Z) + ((size_t)unit * 32 + r) * ZLD + ZC_WLO + n0 + 4 * q;
    mfma_fence4(acc0); mfma_fence4(acc1);
    u32x2 w0, w1; w0.x = cvt_pk_bf16(acc0[0], acc0[1]); w0.y = cvt_pk_bf16(acc0[2], acc0[3]); w1.x = cvt_pk_bf16(acc1[0], acc1[1]); w1.y = cvt_pk_bf16(acc1[2], acc1[3]);
    *(u32x2*)Z = w0; *(u32x2*)(Z + (size_t)16 * ZLD) = w1;
    __syncthreads();
}
__device__ __forceinline__ void moba_select_unit(Frame& F, int unit) {
    const int qb = 1 + (unit >> 4), bh = unit & 15, b = bh >> 3, h = bh & 7;
    const bf16_t* Z = (const bf16_t*)(F.ws + WS_Z); const float* kmp = (const float*)(F.ws + WS_KMP);
    LAS float* km = (LAS float*)(F.lds + att::ATT_LDS);
    LAS unsigned* sel = (LAS unsigned*)(F.lds + att::ATT_LDS + 16 * 132 * 4);
    for (int idx = F.tid; idx < qb * 128; idx += NTHR) { const int n = idx >> 7, d = idx & 127; const int pm = b * 16 + n, col = h * 128 + d;
        km[n * 132 + d] = (kmp[(size_t)(pm * 2 + 0) * 1024 + col] + kmp[(size_t)(pm * 2 + 1) * 1024 + col]) * (1.0f / 256.0f); }
    LDS_WAIT(); __syncthreads();
    {
        int tid_g = F.tid; asm volatile("" : "+v"(tid_g));
        const int row = tid_g >> 1, part = tid_g & 1;
        const bf16_t* qp = Z + (size_t)(b * TSEQ + qb * 256 + row) * ZLD + ZC_Q + h * 128 + part * 64;
        float q[64];
#pragma unroll
        for (int c8 = 0; c8 < 8; ++c8) { float t8[8]; ld8bf(qp + c8 * 8, t8);
#pragma unroll
            for (int e = 0; e < 8; ++e) q[c8 * 8 + e] = t8[e]; }
        float g[15];
#pragma unroll
        for (int n = 0; n < 15; ++n) { float s = 0.f;
            if (n < qb) {
#pragma unroll
                for (int d4 = 0; d4 < 16; ++d4) { const f32x4 kv = *(const LAS f32x4*)(km + n * 132 + part * 64 + d4 * 4);
                    s += (q[d4 * 4] * kv.x + q[d4 * 4 + 1] * kv.y) + (q[d4 * 4 + 2] * kv.z + q[d4 * 4 + 3] * kv.w); }
            }
            s += __shfl_xor(s, 1); g[n] = s; }
        unsigned mask = 0u;
#pragma unroll
        for (int pass = 0; pass < 3; ++pass) { float best = -__builtin_inff(); int bi = -1;
#pragma unroll
            for (int n = 0; n < 15; ++n) { const bool ok = (n < qb) && !((mask >> n) & 1u) && (g[n] > best); best = ok ? g[n] : best; bi = ok ? n : bi; }
            if (bi >= 0) mask |= 1u << bi; }
        if (part == 0) sel[row] = mask;
    }
    LDS_WAIT(); __syncthreads();
    unsigned* CNT = (unsigned*)(F.ws + WS_CTL) + CW_CNT; unsigned* LST = (unsigned*)(F.ws + WS_LST);
    for (int j = F.wave; j < qb; j += NWAVES) {
        unsigned mk[4]; int c = 0;
#pragma unroll
        for (int k = 0; k < 4; ++k) { mk[k] = sel[4 * F.lane + k]; c += (int)((mk[k] >> j) & 1u); }
        int incl = c;
#pragma unroll
        for (int off = 1; off < 64; off <<= 1) { const int up = __shfl_up(incl, off); incl += (F.lane >= off) ? up : 0; }
        const int total = __shfl(incl, 63);
        unsigned base = 0u; if (F.lane == 0) base = __hip_atomic_fetch_add(CNT + bh * 15 + j, (unsigned)total, __ATOMIC_RELAXED, __HIP_MEMORY_SCOPE_AGENT);
        base = (unsigned)__shfl((int)base, 0);
        unsigned off = base + (unsigned)(incl - c); unsigned* lst = LST + (size_t)(bh * 15 + j) * 4096;
#pragma unroll
        for (int k = 0; k < 4; ++k) if ((mk[k] >> j) & 1u) { lst[off++] = (unsigned)(qb * 256 + 4 * F.lane + k) | ((unsigned)__popc(mk[k] & ((1u << j) - 1u)) << 16); }
    }
    __syncthreads();
}
__device__ __forceinline__ void moba_past_phase(Frame& F, int nwork) {
    LAS int* toff = (LAS int*)(F.lds + 100000);
    const unsigned* CNT = (const unsigned*)(F.ws + WS_CTL) + CW_CNT;
    if (F.tid < 240) toff[F.tid + 1] = (int)((CNT[F.tid] + 255u) >> 8);
    LDS_WAIT(); __syncthreads();
    if (F.tid == 0) { int acc = 0; toff[0] = 0; for (int i = 1; i <= 240; ++i) { acc += toff[i]; toff[i] = acc; } }
    LDS_WAIT(); __syncthreads();
    const int T = toff[240];
    for (int g = F.bid < nwork ? F.bid : T; g < T; g += nwork) {
        int lo = 0, hi = 239;
        while (lo < hi) { const int mid = (lo + hi + 1) >> 1; if (toff[mid] <= g) lo = mid; else hi = mid - 1; }
        const int i = lo, bh = i / 15, j = i - bh * 15, tile = g - toff[i], b = bh >> 3, h = bh & 7;
        att::moba_past_tile((const bf16_t*)(F.ws + WS_Z) + (size_t)b * TSEQ * ZLD, h, j, (const unsigned*)(F.ws + WS_LST) + (size_t)i * 4096, (int)CNT[i], tile * 256,
                            (bf16_t*)(F.ws + WS_PART) + (size_t)bh * TSEQ * 384, (float*)(F.ws + WS_ML) + (size_t)bh * TSEQ * 6, F.ldsg);
    }
}
__device__ __forceinline__ void moba_own(Frame& F, int unit) {
    const int qb = unit >> 4, bh = unit & 15, b = bh >> 3, h = bh & 7;
    att::moba_own_unit((const bf16_t*)(F.ws + WS_Z) + (size_t)b * TSEQ * ZLD, h, qb, qb < 3 ? qb : 3, (const bf16_t*)(F.ws + WS_PART) + (size_t)bh * TSEQ * 384, (const float*)(F.ws + WS_ML) + (size_t)bh * TSEQ * 6,
                       (bf16_t*)(F.ws + WS_OB) + (size_t)b * TSEQ * 1024 + h * 128, F.ldsg);
}

__device__ __forceinline__ void sample_kmean_page(Frame& F, int unit) {
    const int b = unit >> 7, pg = unit & 127, cq = F.tid & 255, rg = F.tid >> 8;
    const int page = F.page_table[b * NPG + pg];
    const f32x4* src = (const f32x4*)(F.cache_k + (size_t)page * PAGE * 1024) + cq;
    f32x4 acc = {0.f, 0.f, 0.f, 0.f};
#pragma unroll 16
    for (int r = rg; r < PAGE; r += 2) acc += __builtin_nontemporal_load(src + (size_t)r * 256);
    LAS f32x4* red = (LAS f32x4*)F.lds;
    if (rg == 1) red[cq] = acc;
    LDS_WAIT(); __syncthreads();
    if (rg == 0) { acc += red[cq]; *((f32x4*)((float*)(F.ws + WS_KMS) + (size_t)unit * 1024) + cq) = acc; }
    __syncthreads();
}
__device__ __forceinline__ int queue_pop(Frame& F, unsigned* ctr) {
    volatile LAS int* tk = (volatile LAS int*)(F.lds + LDSCTL_OFF + 64);
    __syncthreads();
    if (F.tid == 0) *tk = (int)__hip_atomic_fetch_add(ctr, 1u, __ATOMIC_RELAXED, __HIP_MEMORY_SCOPE_AGENT);
    __syncthreads();
    return *tk;
}
__device__ __forceinline__ void sample_attn_unit(Frame& F, int unit) {
    const int b = unit >> 3, h = unit & 7;
    const float* ZS = (const float*)(F.ws + WS_ZS) + (size_t)b * ZLD; const float* rope = (const float*)(F.ws + WS_ROPE) + 4096 * 32;
    LAS float* q = (LAS float*)F.lds; LAS float* kn = q + 128; LAS float* sc = kn + 128; LAS float* redm = sc + 800; LAS int* selb = (LAS int*)(redm + 16); LAS float* oacc = redm + 32;
    if (F.tid < 256) {
        const int d = F.tid & 127, isk = F.tid >> 7; const float* src = ZS + (isk ? ZC_KB : ZC_Q) + h * 128;
        float v = src[d];
        if (d < 32) { const int i = d & 15; const float c = rope[i], s = rope[16 + i]; const float x1 = src[i], x2 = src[16 + i]; v = (d < 16) ? (x1 * c - x2 * s) : (x2 * c + x1 * s); }
        (isk ? kn : q)[d] = v;
        if (isk) { F.out[O_KS + (size_t)b * 1024 + h * 128 + d] = v; F.out[O_VS + (size_t)b * 1024 + h * 128 + d] = ZS[ZC_VB + h * 128 + d]; }
    }
    LDS_WAIT(); __syncthreads();
    if (F.wave == 0) {
        const float* km = (const float*)(F.ws + WS_KMS) + ((size_t)b * 128 + 2 * F.lane) * 4 * 1024 + h * 128; float g = 0.f;
        for (int d = 0; d < 128; d += 4) { f32x4 kv = *(const f32x4*)(km + d);
#pragma unroll
            for (int p = 1; p < 8; ++p) kv += *(const f32x4*)(km + (size_t)p * 1024 + d);
            kv = kv * (1.0f / 256.0f); g += (q[d] * kv.x + q[d + 1] * kv.y) + (q[d + 2] * kv.z + q[d + 3] * kv.w); }
        for (int pass = 0; pass < 3; ++pass) { const float mx = wave_max(g); const unsigned long long bal = __ballot(g == mx); const int bi = __ffsll((long long)bal) - 1;
            if (F.lane == 0) selb[pass] = bi; if (F.lane == bi) g = -__builtin_inff(); }
    }
    LDS_WAIT(); __syncthreads();
    LAS int* pgs = selb + 4;
    if (F.tid < 6) pgs[F.tid] = F.page_table[b * NPG + 2 * selb[F.tid >> 1] + (F.tid & 1)];
    LDS_WAIT(); __syncthreads();
    float smax = -__builtin_inff();
    { const int sub = F.lane & 7, kq = F.lane >> 3; float qv[16];
#pragma unroll
      for (int e = 0; e < 16; ++e) qv[e] = q[sub * 16 + e];
      for (int p0 = 0; p0 < 12; p0 += 4) {
          f32x4 kv[4][4];
#pragma unroll
          for (int pp = 0; pp < 4; ++pp) { const int kidx = ((p0 + pp) * 8 + F.wave) * 8 + kq; const float* kr = F.cache_k + ((size_t)pgs[kidx >> 7] * PAGE + (kidx & 127)) * 1024 + h * 128 + sub * 16;
#pragma unroll
              for (int e = 0; e < 4; ++e) kv[pp][e] = *(const f32x4*)(kr + 4 * e); }
#pragma unroll
          for (int pp = 0; pp < 4; ++pp) { const int kidx = ((p0 + pp) * 8 + F.wave) * 8 + kq; float s = 0.f;
#pragma unroll
              for (int e = 0; e < 4; ++e) s += (qv[4 * e] * kv[pp][e].x + qv[4 * e + 1] * kv[pp][e].y) + (qv[4 * e + 2] * kv[pp][e].z + qv[4 * e + 3] * kv[pp][e].w);
              s += __shfl_xor(s, 1); s += __shfl_xor(s, 2); s += __shfl_xor(s, 4);
              s *= att::SCALE; if (sub == 0) sc[kidx] = s; smax = fmaxf(smax, s); } }
      if (F.tid == 0) { float s = 0.f; for (int d = 0; d < 128; ++d) s += q[d] * kn[d]; s *= att::SCALE; sc[768] = s; smax = fmaxf(smax, s); } }
    smax = wave_max(smax); if (F.lane == 0) redm[F.wave] = smax;
    LDS_WAIT(); __syncthreads();
    float mx = redm[0];
#pragma unroll
    for (int w = 1; w < 8; ++w) mx = fmaxf(mx, redm[w]);
    __syncthreads();
    float psum = 0.f;
    for (int kidx = F.tid; kidx < 769; kidx += NTHR) { const float p = __expf(sc[kidx] - mx); sc[kidx] = p; psum += p; }
    psum = wave_sum(psum); if (F.lane == 0) redm[8 + F.wave] = psum;
    LDS_WAIT(); __syncthreads();
    float tot = 0.f;
#pragma unroll
    for (int w = 0; w < 8; ++w) tot += redm[8 + w];
    {
        const int d4 = F.tid & 31, kg = F.tid >> 5; f32x4 a = {0.f, 0.f, 0.f, 0.f};
        for (int k0 = 0; k0 < 48; k0 += 16) {
            f32x4 vv[16];
#pragma unroll
            for (int e = 0; e < 16; ++e) { const int kidx = kg * 48 + k0 + e; vv[e] = *(const f32x4*)(F.cache_v + ((size_t)pgs[kidx >> 7] * PAGE + (kidx & 127)) * 1024 + h * 128 + d4 * 4); }
#pragma unroll
            for (int e = 0; e < 16; ++e) a += vv[e] * sc[kg * 48 + k0 + e];
        }
        *(LAS f32x4*)(oacc + kg * 128 + d4 * 4) = a;
    }
    LDS_WAIT(); __syncthreads();
    if (F.tid < 128) { const int d = F.tid; float a = sc[768] * ZS[ZC_VB + h * 128 + d];
#pragma unroll
        for (int g16 = 0; g16 < 16; ++g16) a += oacc[g16 * 128 + d];
        a = a / tot * siluf_(ZS[ZC_GB + h * 128 + d]);
        ((bf16_t*)(F.ws + WS_OB))[(size_t)(MP + b) * 1024 + h * 128 + d] = (bf16_t)(cvt_pk_bf16(a, a) & 0xffffu); }
    __syncthreads();
}
__device__ __forceinline__ void sample_wkv_unit(Frame& F, int unit, LAS float* scr  ) {
    const int b = unit >> 4, h = unit & 15, j = F.lane, hc = h * 64 + j;
    const float* zc = (const float*)(F.ws + WS_ZS) + (size_t)b * ZLD; const float* zp = (const float*)(F.ws + WS_ZS) + (size_t)(8 + b) * ZLD;
#define LERP1(zcol, muoff) (zc[zcol] + (zp[zcol] - zc[zcol]) * F.mu[muoff])
    const float r = LERP1(ZC_R + hc, hc), k = LERP1(ZC_K + hc, 1088 + hc), v = LERP1(ZC_V + hc, 2112 + hc), g = LERP1(ZC_G + hc, 3200 + hc);
    const float twl = tanhf(LERP1(ZC_WLO + j, 1024 + j)), alo = LERP1(ZC_ALO + j, 3136 + j);
#undef LERP1
    float wl = F.w0[hc], aa = F.a0[hc];
    for (int m = 0; m < 64; ++m) { wl += __shfl(twl, m) * F.w2[(size_t)m * DA + hc]; aa += __shfl(alo, m) * F.a2[(size_t)m * DA + hc]; }
    const float dec = __expf(-0.6065306597126334f * sigmoidf_(wl)), a = sigmoidf_(aa);
    float kk = k * F.k_k[hc]; const float nrm = fmaxf(sqrtf(wave_sum(kk * kk)), 1e-12f); kk = kk / nrm;
    const float kt = k * (1.0f + (a - 1.0f) * F.k_a[hc]), bb = kk * a;
    const float bon = wave_sum(r * kt * F.r_k[hc]);
    scr[j] = dec; scr[64 + j] = kk; scr[128 + j] = bb; scr[192 + j] = kt; scr[256 + j] = r;
    LDS_WAIT(); asm volatile("" ::: "memory");
    const float* Sg = F.st_wkv + ((size_t)(b * 16 + h) * 64 + j) * 64; float* So = F.out + O_WKS + ((size_t)(b * 16 + h) * 64 + j) * 64;
    float S[64];
#pragma unroll
    for (int c4 = 0; c4 < 16; ++c4) { const f32x4 t = *(const f32x4*)(Sg + c4 * 4); S[c4 * 4] = t.x; S[c4 * 4 + 1] = t.y; S[c4 * 4 + 2] = t.z; S[c4 * 4 + 3] = t.w; }
    float sa = 0.f;
#pragma unroll
    for (int c = 0; c < 64; ++c) sa -= S[c] * scr[64 + c];
    float y = 0.f;
#pragma unroll
    for (int c = 0; c < 64; ++c) { S[c] = S[c] * scr[c] + sa * scr[128 + c] + v * scr[192 + c]; y += S[c] * scr[256 + c]; }
#pragma unroll
    for (int c4 = 0; c4 < 16; ++c4) *(f32x4*)(So + c4 * 4) = (f32x4){S[c4 * 4], S[c4 * 4 + 1], S[c4 * 4 + 2], S[c4 * 4 + 3]};
    const float mean = wave_sum(y) * (1.f / 64.f), d = y - mean, var = wave_sum(d * d) * (1.f / 64.f);
    const float yn = d * (1.0f / sqrtf(var + GN_EPS)) * F.lnx_w[hc] + F.lnx_b[hc];
    const float ov = (yn + bon * v) * siluf_(g);
    ((bf16_t*)(F.ws + WS_OA))[(size_t)(MP + b) * 1024 + hc] = (bf16_t)(cvt_pk_bf16(ov, ov) & 0xffffu);
    LDS_WAIT(); asm volatile("" ::: "memory");
}

__device__ __forceinline__ void phase_merge_sample(Frame& F) {
    LAS bf16_t* As = (LAS bf16_t*)F.lds; LAS bf16_t* Bs = As + 16 * (DA + 8);
    stage_rows16<DA>((const bf16_t*)(F.ws + WS_OA) + (size_t)MP * 1024, As, F.tid); stage_rows16<DBB>((const bf16_t*)(F.ws + WS_OB) + (size_t)MP * 1024, Bs, F.tid);
    LDS_WAIT(); __syncthreads();
    const float* ZS = (const float*)(F.ws + WS_ZS); bf16_t* MG = (bf16_t*)(F.ws + WS_MRG) + (size_t)MP * DM;
    const int gw = F.bid * NWAVES + F.wave, NGW = F.G * NWAVES;
    for (int tile = gw; tile < DM / 16; tile += NGW) {
        const f32x4 a = skinny_tile<DA>(As, DA + 8, (const bf16_t*)(F.ws + WS_PAT), tile * 16, F.lane);
        const f32x4 c = skinny_tile<DBB>(Bs, DBB + 8, (const bf16_t*)(F.ws + WS_PBT), tile * 16, F.lane);
        const int q = F.lane >> 4, n = tile * 16 + (F.lane & 15);
        if (q < 2) {
#pragma unroll
            for (int r = 0; r < 4; ++r) { const int m = 4 * q + r; const float ga = sigmoidf_(ZS[(size_t)m * ZLD + ZC_GATE + n]), gb = sigmoidf_(ZS[(size_t)m * ZLD + ZC_GATE + DM + n]);
                const float v = ga * a[r] + gb * c[r]; MG[(size_t)m * DM + n] = (bf16_t)(cvt_pk_bf16(v, v) & 0xffffu); } }
    }
    __syncthreads();
}
__device__ __forceinline__ void phase_out_sample(Frame& F) {
    LAS bf16_t* As = (LAS bf16_t*)F.lds;
    stage_rows16<DM>((const bf16_t*)(F.ws + WS_MRG) + (size_t)MP * DM, As, F.tid);
    LDS_WAIT(); __syncthreads();
    const int gw = F.bid * NWAVES + F.wave, NGW = F.G * NWAVES;
    for (int tile = gw; tile < DM / 16; tile += NGW) {
        const f32x4 a = skinny_tile<DM>(As, DM + 8, (const bf16_t*)(F.ws + WS_WOT), tile * 16, F.lane);
        const int q = F.lane >> 4, n = tile * 16 + (F.lane & 15);
        if (q < 2) {
#pragma unroll
            for (int r = 0; r < 4; ++r) { const int m = 4 * q + r; F.out[O_YS + (size_t)m * DM + n] = F.x_s[(size_t)m * DM + n] + a[r]; } }
    }
    __syncthreads();
}
__device__ __forceinline__ void final_norm_row(Frame& F, float* rowp) {
    f32x4* xr = (f32x4*)rowp + F.lane; const f32x4* wr = (const f32x4*)F.final_w + F.lane;
    f32x4 v[8]; float s = 0.f;
#pragma unroll
    for (int j = 0; j < 8; ++j) { v[j] = xr[64 * j]; s += (v[j].x * v[j].x + v[j].y * v[j].y) + (v[j].z * v[j].z + v[j].w * v[j].w); }
    const float rstd = 1.0f / sqrtf(wave_sum(s) * (1.f / DM) + NORM_EPS);
#pragma unroll
    for (int j = 0; j < 8; ++j) xr[64 * j] = v[j] * rstd * wr[64 * j];
}
namespace wkv {
constexpr int PITCH = 72, SLOT = 64 * PITCH * 2;
constexpr int S_KQ = 0, S_RQ = 1, S_V = 2, S_BBAR = 3, S_KBAR = 4, S_BK = 5, S_KK = 6, S_M = 7, S_N = 8, S_AY = 9, S_BY = 10, S_X0 = 11, S_NV = 12, S_W2 = 13, S_A2 = 14;
constexpr int OFF_RED = 15 * SLOT;
constexpr size_t UNIT_E = 64 * 64;
__device__ __forceinline__ LAS bf16_t* slot(LAS unsigned char* lds, int s) { return (LAS bf16_t*)(lds + s * SLOT); }
__device__ __forceinline__ void frag_row(const LAS bf16_t* img, int r0, int lane, bf16x8 (&f)[2]) {
    const LAS bf16_t* p = img + (r0 + (lane & 15)) * PITCH + 8 * (lane >> 4);
    f[0] = *(const LAS bf16x8*)p; f[1] = *(const LAS bf16x8*)(p + 32);
}
__device__ __forceinline__ void frag_tr(const LAS bf16_t* img, int n0, int lane, bf16x8 (&f)[2]) {
    const int q = lane >> 4, idx = lane & 15;
    const unsigned a = (unsigned)(uintptr_t)(img + (8 * q + (idx >> 2)) * PITCH + n0 + 4 * (idx & 3));
    s16x4 x0, x1, x2, x3;
    asm volatile("ds_read_b64_tr_b16 %0, %1" : "=&v"(x0) : "v"(a) : "memory");
    asm volatile("ds_read_b64_tr_b16 %0, %1 offset:%2" : "=&v"(x1) : "v"(a), "i"(4 * PITCH * 2) : "memory");
    asm volatile("ds_read_b64_tr_b16 %0, %1 offset:%2" : "=&v"(x2) : "v"(a), "i"(32 * PITCH * 2) : "memory");
    asm volatile("ds_read_b64_tr_b16 %0, %1 offset:%2" : "=&v"(x3) : "v"(a), "i"(36 * PITCH * 2) : "memory");
    asm volatile("s_waitcnt lgkmcnt(0)" : "+v"(x0), "+v"(x1), "+v"(x2), "+v"(x3) :: "memory");
    f[0] = (bf16x8){x0[0], x0[1], x0[2], x0[3], x1[0], x1[1], x1[2], x1[3]};
    f[1] = (bf16x8){x2[0], x2[1], x2[2], x2[3], x3[0], x3[1], x3[2], x3[3]};
}
template <bool SWAP> __device__ __forceinline__ void mma(const bf16x8 (&a)[2], const bf16x8 (&b)[2], f32x4& acc) {
#pragma unroll
    for (int ks = 0; ks < 2; ++ks) acc = SWAP ? __builtin_amdgcn_mfma_f32_16x16x32_bf16(b[ks], a[ks], acc, 0, 0, 0) : __builtin_amdgcn_mfma_f32_16x16x32_bf16(a[ks], b[ks], acc, 0, 0, 0);
}
__device__ __forceinline__ void mfma_fence(f32x4& v) { asm volatile("s_nop 7\n\ts_nop 7" : "+v"(v)); }
__device__ __forceinline__ u32x2 pack4(f32x4 v) { u32x2 w; w.x = cvt_pk_bf16(v[0], v[1]); w.y = cvt_pk_bf16(v[2], v[3]); return w; }
__device__ __forceinline__ f32x4 unpack4(u32x2 w) { return (f32x4){bflo(w.x), bfhi(w.x), bflo(w.y), bfhi(w.y)}; }
__device__ __forceinline__ void st_img(LAS bf16_t* img, int m0, int n0, int lane, f32x4 v) { mfma_fence(v); *(LAS u32x2*)(img + (m0 + (lane & 15)) * PITCH + n0 + 4 * (lane >> 4)) = pack4(v); }
__device__ __forceinline__ f32x4 ld_img(const LAS bf16_t* img, int m0, int n0, int lane) { return unpack4(*(const LAS u32x2*)(img + (m0 + (lane & 15)) * PITCH + n0 + 4 * (lane >> 4))); }
#define WKV_BAR() do { asm volatile("s_waitcnt lgkmcnt(0)" ::: "memory"); __builtin_amdgcn_s_barrier(); asm volatile("" ::: "memory"); } while (0)

struct TrRaw { s16x4 x0, x1, x2, x3; };
__device__ __forceinline__ void tr_issue(const LAS bf16_t* img, int n0, int lane, TrRaw& t) {
    const int q = lane >> 4, idx = lane & 15;
    const unsigned a = (unsigned)(uintptr_t)(img + (8 * q + (idx >> 2)) * PITCH + n0 + 4 * (idx & 3));
    asm volatile("ds_read_b64_tr_b16 %0, %1" : "=&v"(t.x0) : "v"(a) : "memory");
    asm volatile("ds_read_b64_tr_b16 %0, %1 offset:%2" : "=&v"(t.x1) : "v"(a), "i"(4 * PITCH * 2) : "memory");
    asm volatile("ds_read_b64_tr_b16 %0, %1 offset:%2" : "=&v"(t.x2) : "v"(a), "i"(32 * PITCH * 2) : "memory");
    asm volatile("ds_read_b64_tr_b16 %0, %1 offset:%2" : "=&v"(t.x3) : "v"(a), "i"(36 * PITCH * 2) : "memory");
}
#define TRV(t) "+v"(t.x0), "+v"(t.x1), "+v"(t.x2), "+v"(t.x3)
#define TR_WAIT2(a, b) asm volatile("s_waitcnt lgkmcnt(0)" : TRV(a), TRV(b) :: "memory")
#define TR_WAIT4(a, b, c, d) asm volatile("s_waitcnt lgkmcnt(0)" : TRV(a), TRV(b), TRV(c), TRV(d) :: "memory")
#define TR_WAIT6(a, b, c, d, e, f) asm volatile("s_waitcnt lgkmcnt(0)" : TRV(a), TRV(b), TRV(c), TRV(d), TRV(e), TRV(f) :: "memory")
#define TR_WAIT7(a, b, c, d, e, f, g) asm volatile("s_waitcnt lgkmcnt(0)" : TRV(a), TRV(b), TRV(c), TRV(d), TRV(e), TRV(f), TRV(g) :: "memory")
__device__ __forceinline__ void tr_frag(const TrRaw& t, bf16x8 (&f)[2]) {
    f[0] = (bf16x8){t.x0[0], t.x0[1], t.x0[2], t.x0[3], t.x1[0], t.x1[1], t.x1[2], t.x1[3]};
    f[1] = (bf16x8){t.x2[0], t.x2[1], t.x2[2], t.x2[3], t.x3[0], t.x3[1], t.x3[2], t.x3[3]};
}
constexpr int OFF_CST = OFF_RED + 4352;
constexpr int STP = 392;
__device__ __forceinline__ void st_fetch(const bf16_t* Z, int b, int h, int c, int tid, u32x4 (&pf)[7]) {
    const bf16_t* zb = Z + ((size_t)b * TSEQ + (size_t)c * 64) * ZLD;
#pragma unroll
    for (int i = 0; i < 7; ++i) { const int idx = tid + NTHR * i; pf[i] = (u32x4){0u, 0u, 0u, 0u};
        if (idx < 65 * 48) { const int rw = idx / 48, rem = idx - rw * 48, reg = rem >> 3, ch = rem & 7;
            const int col = (reg < 4) ? (reg * 1024 + h * 64) : (reg == 4 ? ZC_WLO : ZC_ALO);
            if (rw > 0 || c > 0) pf[i] = *(const u32x4*)(zb + ((ptrdiff_t)rw - 1) * ZLD + col + ch * 8); } }
}
__device__ __forceinline__ void scanA_unit(Frame& F, int bh, int c, bool load_w, u32x4 (&pf)[7], int nbh, int nc, bool has_next, const float* kmsrc, float* kmdst) {
    int tid = F.tid; asm volatile("" : "+v"(tid));
    const int lane = tid & 63, wv = F.wave, tt = lane, cg = wv;
    const int b = bh >> 4, h = bh & 15;
    const size_t uid = (size_t)bh * 64 + c;
    LAS unsigned char* L = F.lds;
    LAS float* red = (LAS float*)(L + OFF_RED); LAS float* red2 = red + 512; LAS float* gC = red2 + 512; LAS float* cst = (LAS float*)(L + OFF_CST);
    LAS float* WLf = (LAS float*)(L + S_X0 * SLOT); LAS float* AAf = (LAS float*)(L + S_M * SLOT);
    const bf16_t* Z = (const bf16_t*)(F.ws + WS_Z);
    if (load_w) {
        const int m = tid >> 3, j = (tid & 7) * 8; float t8[8];
        ld8f(F.w2 + (size_t)m * DA + h * 64 + j, t8); *(LAS u32x4*)(slot(L, S_W2) + m * PITCH + j) = (u32x4){cvt_pk_bf16(t8[0], t8[1]), cvt_pk_bf16(t8[2], t8[3]), cvt_pk_bf16(t8[4], t8[5]), cvt_pk_bf16(t8[6], t8[7])};
        ld8f(F.a2 + (size_t)m * DA + h * 64 + j, t8); *(LAS u32x4*)(slot(L, S_A2) + m * PITCH + j) = (u32x4){cvt_pk_bf16(t8[0], t8[1]), cvt_pk_bf16(t8[2], t8[3]), cvt_pk_bf16(t8[4], t8[5]), cvt_pk_bf16(t8[6], t8[7])};
#pragma unroll
        for (int i = 0; i < 2; ++i) { const int idx = tid + NTHR * i;
            if (idx < 11 * 64) { const int k = idx >> 6, jj = idx & 63, hj = h * 64 + jj; float v;
                switch (k) { case 0: v = F.mu[hj]; break; case 1: v = F.mu[1088 + hj]; break; case 2: v = F.mu[2112 + hj]; break; case 3: v = F.mu[3200 + hj]; break;
                             case 4: v = F.mu[1024 + jj]; break; case 5: v = F.mu[3136 + jj]; break; case 6: v = F.w0[hj]; break; case 7: v = F.a0[hj]; break;
                             case 8: v = F.k_k[hj]; break; case 9: v = F.k_a[hj]; break; default: v = F.r_k[hj]; break; }
                cst[idx] = v; } }
    }
    LAS bf16_t* ST = (LAS bf16_t*)L;
#pragma unroll
    for (int i = 0; i < 7; ++i) { const int idx = tid + NTHR * i;
        if (idx < 65 * 48) { const int rw = idx / 48, rem = idx - rw * 48, reg = rem >> 3, ch = rem & 7; *(LAS u32x4*)(ST + rw * STP + reg * 64 + ch * 8) = pf[i]; } }
    f32x4 kst[8], kacc = {0.f, 0.f, 0.f, 0.f};
#define KM_ISSUE(bt) do { _Pragma("unroll") for (int i = 0; i < 8; ++i) kst[i] = __builtin_nontemporal_load((const f32x4*)(kmsrc + (size_t)(16 * (bt) + 2 * i) * 1024)); } while (0)
#define KM_SUM() do { _Pragma("unroll") for (int i = 0; i < 8; ++i) kacc += kst[i]; } while (0)
    KM_ISSUE(0);
    WKV_BAR();
    float r8[8], k8[8], v8[8], g8[8];
#define LERP8(dst, reg_) do { float cur_[8], prv_[8], mu_[8]; ld8bf_lds(ST + (tt + 1) * STP + (reg_) * 64 + cg * 8, cur_); ld8bf_lds(ST + tt * STP + (reg_) * 64 + cg * 8, prv_); ld8f_lds(cst + (reg_) * 64 + cg * 8, mu_); \
        _Pragma("unroll") for (int e = 0; e < 8; ++e) dst[e] = cur_[e] + (prv_[e] - cur_[e]) * mu_[e]; } while (0)
    LERP8(r8, 0); LERP8(k8, 1); LERP8(v8, 2); LERP8(g8, 3);
    float wl8[8], al8[8]; LERP8(wl8, 4); LERP8(al8, 5);
#undef LERP8
#pragma unroll
    for (int e = 0; e < 8; ++e) wl8[e] = 1.0f - 2.0f * __builtin_amdgcn_rcpf(1.0f + __builtin_amdgcn_exp2f(2.8853900817779268f * wl8[e]));
    *(LAS u32x4*)(slot(L, S_AY) + tt * PITCH + cg * 8) = (u32x4){cvt_pk_bf16(wl8[0], wl8[1]), cvt_pk_bf16(wl8[2], wl8[3]), cvt_pk_bf16(wl8[4], wl8[5]), cvt_pk_bf16(wl8[6], wl8[7])};
    *(LAS u32x4*)(slot(L, S_BY) + tt * PITCH + cg * 8) = (u32x4){cvt_pk_bf16(al8[0], al8[1]), cvt_pk_bf16(al8[2], al8[3]), cvt_pk_bf16(al8[4], al8[5]), cvt_pk_bf16(al8[6], al8[7])};
    float kk[8];
    { float kkc[8]; ld8f_lds(cst + 8 * 64 + cg * 8, kkc); float ss = 0.f;
#pragma unroll
      for (int e = 0; e < 8; ++e) { kk[e] = k8[e] * kkc[e]; ss += kk[e] * kk[e]; }
      red[tt * 8 + cg] = ss; }
    WKV_BAR();
    const int mt = wv & 3, ntp = wv >> 2, m0 = mt * 16, n0 = ntp * 32;
    { bf16x8 a[2], a2[2], b0[2], b1[2]; TrRaw t0, t1, t2, t3;
      frag_row(slot(L, S_AY), m0, lane, a); frag_row(slot(L, S_BY), m0, lane, a2);
      tr_issue(slot(L, S_W2), n0, lane, t0); tr_issue(slot(L, S_W2), n0 + 16, lane, t1); tr_issue(slot(L, S_A2), n0, lane, t2); tr_issue(slot(L, S_A2), n0 + 16, lane, t3);
      TR_WAIT4(t0, t1, t2, t3);
      f32x4 c0 = {0.f, 0.f, 0.f, 0.f}, c1 = c0, d0 = c0, d1 = c0;
      tr_frag(t0, b0); tr_frag(t1, b1); mma<true>(a, b0, c0); mma<true>(a, b1, c1);
      tr_frag(t2, b0); tr_frag(t3, b1); mma<true>(a2, b0, d0); mma<true>(a2, b1, d1);
      const int rr = m0 + (lane & 15), cc = n0 + 4 * (lane >> 4);
      *(LAS f32x4*)(WLf + rr * 68 + cc) = c0; *(LAS f32x4*)(WLf + rr * 68 + cc + 16) = c1;
      *(LAS f32x4*)(AAf + rr * 68 + cc) = d0; *(LAS f32x4*)(AAf + rr * 68 + cc + 16) = d1; }
    WKV_BAR();
    KM_SUM();
    float bon_part;
    { float wl[8], aa[8], t8[8];
      ld8f_lds(cst + 6 * 64 + cg * 8, t8);
#pragma unroll
      for (int e = 0; e < 8; ++e) wl[e] = t8[e] + WLf[tt * 68 + cg * 8 + e];
      ld8f_lds(cst + 7 * 64 + cg * 8, t8);
#pragma unroll
      for (int e = 0; e < 8; ++e) aa[e] = t8[e] + AAf[tt * 68 + cg * 8 + e];
      float tot = 0.f;
#pragma unroll
      for (int e = 0; e < 8; ++e) tot += red[tt * 8 + e];
      const float inv = 1.0f / fmaxf(sqrtf(tot), 1e-12f);
      float kac[8], rkc[8]; ld8f_lds(cst + 9 * 64 + cg * 8, kac); ld8f_lds(cst + 10 * 64 + cg * 8, rkc);
      float ew[8], cum[8], av[8], kt[8], bb[8];
      bon_part = 0.f;
#pragma unroll
      for (int e = 0; e < 8; ++e) { ew[e] = 0.6065306597126334f * sigmoidf_(wl[e]); cum[e] = ew[e]; av[e] = sigmoidf_(aa[e]); kk[e] *= inv;
          kt[e] = k8[e] * (1.0f + (av[e] - 1.0f) * kac[e]); bb[e] = kk[e] * av[e]; bon_part += r8[e] * kt[e] * rkc[e]; }
#pragma unroll
      for (int off = 1; off < 64; off <<= 1) {
#pragma unroll
          for (int e = 0; e < 8; ++e) { const float up = __shfl_up(cum[e], off); cum[e] += (lane >= off) ? up : 0.f; } }
      float okq[8], orq[8], obk[8], okk[8], okb[8], obb[8];
#pragma unroll
      for (int e = 0; e < 8; ++e) { const float Lc = cum[e], LC = __shfl(cum[e], 63);
          const float ein = __expf(-Lc), eex = __expf(ew[e] - Lc), epl = __expf(Lc), erem = __expf(Lc - LC);
          okq[e] = kk[e] * eex; orq[e] = r8[e] * ein; obk[e] = bb[e] * epl; okk[e] = kt[e] * epl; okb[e] = kt[e] * erem; obb[e] = bb[e] * erem;
          if (tt == 0) gC[cg * 8 + e] = __expf(-LC); }
#define ST8(slot_, arr) *(LAS u32x4*)(slot(L, slot_) + tt * PITCH + cg * 8) = (u32x4){cvt_pk_bf16(arr[0], arr[1]), cvt_pk_bf16(arr[2], arr[3]), cvt_pk_bf16(arr[4], arr[5]), cvt_pk_bf16(arr[6], arr[7])}
      ST8(S_KQ, okq); ST8(S_RQ, orq); ST8(S_BK, obk); ST8(S_KK, okk); ST8(S_KBAR, okb); ST8(S_BBAR, obb); ST8(S_V, v8);
#undef ST8
      red2[tt * 8 + cg] = bon_part; }
    WKV_BAR();
    if (has_next) st_fetch(Z, nbh >> 4, nbh & 15, nc, tid, pf);
    KM_ISSUE(1);
    { float bt = 0.f;
#pragma unroll
      for (int e = 0; e < 8; ++e) bt += red2[tt * 8 + e];
      bf16_t* BV = (bf16_t*)(F.ws + WS_CBV) + uid * UNIT_E + tt * 64 + cg * 8; bf16_t* SG = (bf16_t*)(F.ws + WS_CSG) + uid * UNIT_E + tt * 64 + cg * 8;
      *(u32x4*)BV = (u32x4){cvt_pk_bf16(bt * v8[0], bt * v8[1]), cvt_pk_bf16(bt * v8[2], bt * v8[3]), cvt_pk_bf16(bt * v8[4], bt * v8[5]), cvt_pk_bf16(bt * v8[6], bt * v8[7])};
      *(u32x4*)SG = (u32x4){cvt_pk_bf16(siluf_(g8[0]), siluf_(g8[1])), cvt_pk_bf16(siluf_(g8[2]), siluf_(g8[3])), cvt_pk_bf16(siluf_(g8[4]), siluf_(g8[5])), cvt_pk_bf16(siluf_(g8[6]), siluf_(g8[7]))}; }
    const int tr_ = m0 + (lane & 15), sc0 = n0 + 4 * (lane >> 4);
    { bf16x8 akq[2], arq[2], bbk0[2], bbk1[2], bkk0[2], bkk1[2];
      frag_row(slot(L, S_KQ), m0, lane, akq); frag_row(slot(L, S_RQ), m0, lane, arq);
      frag_row(slot(L, S_BK), n0, lane, bbk0); frag_row(slot(L, S_BK), n0 + 16, lane, bbk1); frag_row(slot(L, S_KK), n0, lane, bkk0); frag_row(slot(L, S_KK), n0 + 16, lane, bkk1);
      f32x4 z = {0.f, 0.f, 0.f, 0.f}; f32x4 m_0 = z, m_1 = z, n_0 = z, n_1 = z, ay0 = z, ay1 = z, by0 = z, by1 = z;
      mma<true>(akq, bbk0, m_0); mma<true>(akq, bbk1, m_1); mma<true>(akq, bkk0, n_0); mma<true>(akq, bkk1, n_1);
      mma<true>(arq, bkk0, ay0); mma<true>(arq, bkk1, ay1); mma<true>(arq, bbk0, by0); mma<true>(arq, bbk1, by1);
      f32x4 x0, x1;
#pragma unroll
      for (int r = 0; r < 4; ++r) { const int s0 = sc0 + r, s1 = sc0 + 16 + r;
          m_0[r] = (s0 < tr_) ? m_0[r] : 0.f; m_1[r] = (s1 < tr_) ? m_1[r] : 0.f; n_0[r] = (s0 < tr_) ? n_0[r] : 0.f; n_1[r] = (s1 < tr_) ? n_1[r] : 0.f;
          ay0[r] = (s0 <= tr_) ? ay0[r] : 0.f; ay1[r] = (s1 <= tr_) ? ay1[r] : 0.f; by0[r] = (s0 <= tr_) ? by0[r] : 0.f; by1[r] = (s1 <= tr_) ? by1[r] : 0.f;
          x0[r] = ((s0 == tr_) ? 1.f : 0.f) - m_0[r]; x1[r] = ((s1 == tr_) ? 1.f : 0.f) - m_1[r]; }
      st_img(slot(L, S_M), m0, n0, lane, m_0); st_img(slot(L, S_M), m0, n0 + 16, lane, m_1); st_img(slot(L, S_N), m0, n0, lane, n_0); st_img(slot(L, S_N), m0, n0 + 16, lane, n_1);
      st_img(slot(L, S_AY), m0, n0, lane, ay0); st_img(slot(L, S_AY), m0, n0 + 16, lane, ay1); st_img(slot(L, S_BY), m0, n0, lane, by0); st_img(slot(L, S_BY), m0, n0 + 16, lane, by1);
      st_img(slot(L, S_X0), m0, n0, lane, x0); st_img(slot(L, S_X0), m0, n0 + 16, lane, x1); }
    WKV_BAR();
#define NEUMANN_ROUND(PIN, POUT, XIN, XOUT, DO_P, DO_X, DO_NV) do {                                                           \
        bf16x8 ap[2], ax[2], an[2], bp0[2], bp1[2], bv0[2], bv1[2]; TrRaw tp0, tp1, tv0, tv1; f32x4 x0, x1;                       \
        if (DO_P) frag_row(slot(L, PIN), m0, lane, ap);                                                                         \
        if (DO_X) { frag_row(slot(L, XIN), m0, lane, ax); x0 = ld_img(slot(L, XIN), m0, n0, lane); x1 = ld_img(slot(L, XIN), m0, n0 + 16, lane); } \
        if (DO_NV) frag_row(slot(L, S_N), m0, lane, an);                                                                        \
        tr_issue(slot(L, PIN), n0, lane, tp0); tr_issue(slot(L, PIN), n0 + 16, lane, tp1);                                      \
        if (DO_NV) { tr_issue(slot(L, S_V), n0, lane, tv0); tr_issue(slot(L, S_V), n0 + 16, lane, tv1); TR_WAIT4(tp0, tp1, tv0, tv1); } else { TR_WAIT2(tp0, tp1); } \
        tr_frag(tp0, bp0); tr_frag(tp1, bp1);                                                                                    \
        if (DO_P) { f32x4 p0 = {0.f, 0.f, 0.f, 0.f}, p1 = p0; mma<true>(ap, bp0, p0); mma<true>(ap, bp1, p1);                      \
                    st_img(slot(L, POUT), m0, n0, lane, p0); st_img(slot(L, POUT), m0, n0 + 16, lane, p1); }                      \
        if (DO_X) { mma<true>(ax, bp0, x0); mma<true>(ax, bp1, x1); st_img(slot(L, XOUT), m0, n0, lane, x0); st_img(slot(L, XOUT), m0, n0 + 16, lane, x1); } \
        if (DO_NV) { tr_frag(tv0, bv0); tr_frag(tv1, bv1); f32x4 v0 = {0.f, 0.f, 0.f, 0.f}, v1 = v0; mma<true>(an, bv0, v0); mma<true>(an, bv1, v1); \
                     st_img(slot(L, S_NV), m0, n0, lane, v0); st_img(slot(L, S_NV), m0, n0 + 16, lane, v1); }                       \
        WKV_BAR(); } while (0)
    NEUMANN_ROUND(S_M, S_BK, S_X0, S_X0, true, false, true);
    NEUMANN_ROUND(S_BK, S_M, S_X0, S_KK, true, true, false);
    KM_SUM(); KM_ISSUE(2);
    NEUMANN_ROUND(S_M, S_BK, S_KK, S_X0, true, true, false);
    NEUMANN_ROUND(S_BK, S_M, S_X0, S_KK, true, true, false);
    NEUMANN_ROUND(S_M, S_BK, S_KK, S_X0, true, true, false);
    KM_SUM(); KM_ISSUE(3);
    NEUMANN_ROUND(S_BK, S_M, S_X0, S_KK, false, true, false);
#undef NEUMANN_ROUND
    { bf16x8 at[2], b0[2], b1[2]; TrRaw t0, t1, t2, t3; frag_row(slot(L, S_KK), m0, lane, at);
      tr_issue(slot(L, S_KQ), n0, lane, t0); tr_issue(slot(L, S_KQ), n0 + 16, lane, t1); tr_issue(slot(L, S_NV), n0, lane, t2); tr_issue(slot(L, S_NV), n0 + 16, lane, t3);
      TR_WAIT4(t0, t1, t2, t3);
      tr_frag(t0, b0); tr_frag(t1, b1);
      f32x4 w0 = {0.f, 0.f, 0.f, 0.f}, w1 = w0; mma<true>(at, b0, w0); mma<true>(at, b1, w1);
      st_img(slot(L, S_M), m0, n0, lane, w0); st_img(slot(L, S_M), m0, n0 + 16, lane, w1);
      tr_frag(t2, b0); tr_frag(t3, b1);
      f32x4 u0 = {0.f, 0.f, 0.f, 0.f}, u1 = u0; mma<true>(at, b0, u0); mma<true>(at, b1, u1);
      st_img(slot(L, S_N), m0, n0, lane, -u0); st_img(slot(L, S_N), m0, n0 + 16, lane, -u1); }
    WKV_BAR();
    { const int c16 = lane & 15, q4 = 4 * (lane >> 4);
      bf16x8 a[2], a2[2], b0[2], b1[2], c0[2], c1[2];
      TrRaw tw, tbb0, tbb1, tv, tnu, tkb0, tkb1;
      tr_issue(slot(L, S_M), m0, lane, tw); tr_issue(slot(L, S_BBAR), n0, lane, tbb0); tr_issue(slot(L, S_BBAR), n0 + 16, lane, tbb1);
      tr_issue(slot(L, S_V), m0, lane, tv); tr_issue(slot(L, S_N), m0, lane, tnu); tr_issue(slot(L, S_KBAR), n0, lane, tkb0); tr_issue(slot(L, S_KBAR), n0 + 16, lane, tkb1);
      TR_WAIT7(tw, tbb0, tbb1, tv, tnu, tkb0, tkb1);
      tr_frag(tw, a); tr_frag(tbb0, b0); tr_frag(tbb1, b1);
      { f32x4 p0 = {0.f, 0.f, 0.f, 0.f}, p1 = p0; mma<false>(a, b0, p0); mma<false>(a, b1, p1);
#pragma unroll
        for (int r = 0; r < 4; ++r) { const int j = m0 + q4 + r; const float gd = gC[j]; p0[r] = ((j == n0 + c16) ? gd : 0.f) - p0[r]; p1[r] = ((j == n0 + 16 + c16) ? gd : 0.f) - p1[r]; }
        bf16_t* PT = (bf16_t*)(F.ws + WS_CPM) + uid * UNIT_E;
        *(u32x2*)(PT + (size_t)(n0 + c16) * 64 + m0 + q4) = pack4(p0); *(u32x2*)(PT + (size_t)(n0 + 16 + c16) * 64 + m0 + q4) = pack4(p1); }
      tr_frag(tv, a); tr_frag(tnu, a2); tr_frag(tkb0, c0); tr_frag(tkb1, c1);
      { f32x4 q0 = {0.f, 0.f, 0.f, 0.f}, q1 = q0; mma<true>(a, c0, q0); mma<true>(a, c1, q1); mma<true>(a2, b0, q0); mma<true>(a2, b1, q1);
        float* QG = (float*)(F.ws + WS_CQ) + uid * UNIT_E + (size_t)(m0 + c16) * 64 + n0 + q4; *(f32x4*)QG = q0; *(f32x4*)(QG + 16) = q1; }
      TrRaw tw0, tw1, tv0, tv1, tn0, tn1;
      frag_row(slot(L, S_BY), m0, lane, a); frag_row(slot(L, S_AY), m0, lane, a2);
      const f32x4 r0 = ld_img(slot(L, S_RQ), m0, n0, lane), r1 = ld_img(slot(L, S_RQ), m0, n0 + 16, lane);
      tr_issue(slot(L, S_M), n0, lane, tw0); tr_issue(slot(L, S_M), n0 + 16, lane, tw1); tr_issue(slot(L, S_V), n0, lane, tv0); tr_issue(slot(L, S_V), n0 + 16, lane, tv1);
      tr_issue(slot(L, S_N), n0, lane, tn0); tr_issue(slot(L, S_N), n0 + 16, lane, tn1);
      TR_WAIT6(tw0, tw1, tv0, tv1, tn0, tn1);
      tr_frag(tw0, b0); tr_frag(tw1, b1);
      { f32x4 y0 = {0.f, 0.f, 0.f, 0.f}, y1 = y0; mma<true>(a, b0, y0); mma<true>(a, b1, y1);
        bf16_t* YQ = (bf16_t*)(F.ws + WS_CYQ) + uid * UNIT_E + (size_t)(m0 + c16) * 64 + n0 + q4; *(u32x2*)YQ = pack4(r0 - y0); *(u32x2*)(YQ + 16) = pack4(r1 - y1); }
      tr_frag(tv0, b0); tr_frag(tv1, b1); tr_frag(tn0, c0); tr_frag(tn1, c1);
      { f32x4 y0 = {0.f, 0.f, 0.f, 0.f}, y1 = y0; mma<true>(a2, b0, y0); mma<true>(a2, b1, y1); mma<true>(a, c0, y0); mma<true>(a, c1, y1);
        float* YL = (float*)(F.ws + WS_CYL) + uid * UNIT_E + (size_t)(m0 + c16) * 64 + n0 + q4; *(f32x4*)YL = y0; *(f32x4*)(YL + 16) = y1; } }
    KM_SUM();
    *(f32x4*)kmdst = kacc;
#undef KM_ISSUE
#undef KM_SUM
    WKV_BAR();
}

__device__ __forceinline__ void scanB_unit(Frame& F, int unit) {
    int tid = F.tid; asm volatile("" : "+v"(tid));
    const int bh = unit >> 1, half = unit & 1;
    const int lane = tid & 63, wv = F.wave, ml0 = (wv & 1) * 16, m0 = half * 32 + ml0, n0 = (wv >> 1) * 16, c16 = lane & 15, q4 = 4 * (lane >> 4);
    LAS unsigned char* L = F.lds;
    const bf16_t* PT = (const bf16_t*)(F.ws + WS_CPM) + (size_t)bh * 64 * UNIT_E; const float* QG = (const float*)(F.ws + WS_CQ) + (size_t)bh * 64 * UNIT_E;
    bf16_t* SC = (bf16_t*)(F.ws + WS_CSC) + (size_t)bh * 64 * UNIT_E;
    f32x4 s = {0.f, 0.f, 0.f, 0.f};
    const size_t boff = (size_t)(n0 + c16) * 64 + 2 * q4, qoff = (size_t)(m0 + c16) * 64 + n0 + q4;
    bf16x8 P0[2], P1[2], P2[2], P3[2], P4[2], P5[2], P6[2], P7[2]; f32x4 Q0, Q1, Q2, Q3, Q4, Q5, Q6, Q7;
#define SB_LOAD(P, Q, cc) do { const int c_ = (cc) < 64 ? (cc) : 63; const bf16_t* PTn = PT + (size_t)c_ * UNIT_E + boff;                                  \
        P[0] = *(const bf16x8*)PTn; P[1] = *(const bf16x8*)(PTn + 32); Q = *(const f32x4*)(QG + (size_t)c_ * UNIT_E + qoff); } while (0)
#define SB_STEP(cc, P, Q) do { LAS bf16_t* simg = slot(L, (cc) & 1);                                                                                    \
        mfma_fence(s); const u32x2 w = pack4(s);                                                                                                         \
        *(LAS u32x2*)(simg + (ml0 + c16) * PITCH + n0 + q4) = w;                                                                                        \
        *(u32x2*)(SC + (size_t)(cc) * UNIT_E + (size_t)(m0 + c16) * 64 + n0 + q4) = w;                                                                   \
        asm volatile("s_waitcnt lgkmcnt(0)" ::: "memory"); __builtin_amdgcn_s_barrier(); asm volatile("" ::: "memory");                                 \
        bf16x8 a[2]; frag_row(simg, ml0, lane, a);                                                                                                        \
        s = Q; mma<true>(a, P, s);                                                                                                                        \
        SB_LOAD(P, Q, (cc) + 8); } while (0)
    SB_LOAD(P0, Q0, 0); SB_LOAD(P1, Q1, 1); SB_LOAD(P2, Q2, 2); SB_LOAD(P3, Q3, 3); SB_LOAD(P4, Q4, 4); SB_LOAD(P5, Q5, 5); SB_LOAD(P6, Q6, 6); SB_LOAD(P7, Q7, 7);
    for (int c = 0; c < 64; c += 8) {
        SB_STEP(c, P0, Q0); SB_STEP(c + 1, P1, Q1); SB_STEP(c + 2, P2, Q2); SB_STEP(c + 3, P3, Q3);
        SB_STEP(c + 4, P4, Q4); SB_STEP(c + 5, P5, Q5); SB_STEP(c + 6, P6, Q6); SB_STEP(c + 7, P7, Q7);
    }
#undef SB_LOAD
#undef SB_STEP
    mfma_fence(s);
    *(f32x4*)(F.out + O_WKP + (size_t)bh * 4096 + (size_t)(m0 + c16) * 64 + n0 + q4) = s;
    WKV_BAR();
}

__device__ __forceinline__ void scanC_unit(Frame& F, int bh, int c) {
    int tid = F.tid; asm volatile("" : "+v"(tid));
    const int lane = tid & 63, wv = F.wave, mt = wv & 3, ntp = wv >> 2, m0 = mt * 16, n0 = ntp * 32, c16 = lane & 15, q4 = 4 * (lane >> 4);
    const size_t uid = (size_t)bh * 64 + c; const int b = bh >> 4, h = bh & 15;
    LAS float* Yf = (LAS float*)F.lds;
    const bf16_t* YQ = (const bf16_t*)(F.ws + WS_CYQ) + uid * UNIT_E; const bf16_t* SC = (const bf16_t*)(F.ws + WS_CSC) + uid * UNIT_E; const float* YL = (const float*)(F.ws + WS_CYL) + uid * UNIT_E;
    bf16x8 a[2], b0[2], b1[2];
    { const bf16_t* ap = YQ + (size_t)(m0 + c16) * 64 + 2 * q4; a[0] = *(const bf16x8*)ap; a[1] = *(const bf16x8*)(ap + 32);
      const bf16_t* bp = SC + (size_t)(n0 + c16) * 64 + 2 * q4; b0[0] = *(const bf16x8*)bp; b0[1] = *(const bf16x8*)(bp + 32); b1[0] = *(const bf16x8*)(bp + 16 * 64); b1[1] = *(const bf16x8*)(bp + 16 * 64 + 32); }
    f32x4 y0 = *(const f32x4*)(YL + (size_t)(m0 + c16) * 64 + n0 + q4), y1 = *(const f32x4*)(YL + (size_t)(m0 + c16) * 64 + n0 + 16 + q4);
    mma<true>(a, b0, y0); mma<true>(a, b1, y1);
    *(LAS f32x4*)(Yf + (m0 + c16) * 68 + n0 + q4) = y0; *(LAS f32x4*)(Yf + (m0 + c16) * 68 + n0 + 16 + q4) = y1;
    WKV_BAR();
    { const int tt = tid >> 3, ig = tid & 7; float y[8];
      const f32x4 ya = *(const LAS f32x4*)(Yf + tt * 68 + ig * 8), yb = *(const LAS f32x4*)(Yf + tt * 68 + ig * 8 + 4);
      y[0] = ya.x; y[1] = ya.y; y[2] = ya.z; y[3] = ya.w; y[4] = yb.x; y[5] = yb.y; y[6] = yb.z; y[7] = yb.w;
      float s = 0.f;
#pragma unroll
      for (int e = 0; e < 8; ++e) s += y[e];
      s += __shfl_xor(s, 1); s += __shfl_xor(s, 2); s += __shfl_xor(s, 4);
      const float mean = s * (1.f / 64.f); float vq = 0.f;
#pragma unroll
      for (int e = 0; e < 8; ++e) { y[e] -= mean; vq += y[e] * y[e]; }
      vq += __shfl_xor(vq, 1); vq += __shfl_xor(vq, 2); vq += __shfl_xor(vq, 4);
      const float rstd = 1.0f / sqrtf(vq * (1.f / 64.f) + GN_EPS);
      float lw[8], lb[8], bv[8], sg[8];
      ld8f(F.lnx_w + h * 64 + ig * 8, lw); ld8f(F.lnx_b + h * 64 + ig * 8, lb);
      ld8bf((const bf16_t*)(F.ws + WS_CBV) + uid * UNIT_E + tt * 64 + ig * 8, bv); ld8bf((const bf16_t*)(F.ws + WS_CSG) + uid * UNIT_E + tt * 64 + ig * 8, sg);
      float o[8];
#pragma unroll
      for (int e = 0; e < 8; ++e) o[e] = (y[e] * rstd * lw[e] + lb[e] + bv[e]) * sg[e];
      bf16_t* OA = (bf16_t*)(F.ws + WS_OA) + ((size_t)b * TSEQ + c * 64 + tt) * 1024 + h * 64 + ig * 8;
      *(u32x4*)OA = (u32x4){cvt_pk_bf16(o[0], o[1]), cvt_pk_bf16(o[2], o[3]), cvt_pk_bf16(o[4], o[5]), cvt_pk_bf16(o[6], o[7])}; }
    WKV_BAR();
}
}
#ifndef MK_N_LAUNCHES
#define MK_N_LAUNCHES 1
#endif
constexpr int N_PHASES = 8;
#ifndef REP0
#define REP0 1
#endif
#ifndef REP1
#define REP1 1
#endif
#ifndef REP2
#define REP2 1
#endif
#ifndef REP3
#define REP3 1
#endif
#ifndef REP4
#define REP4 1
#endif
#ifndef REP5
#define REP5 1
#endif
#ifndef REP6
#define REP6 1
#endif
__device__ __forceinline__ void phase1(Frame& F) {
    pg8::Gemm g{(const bf16_t*)(F.ws + WS_XN), (const bf16_t*)(F.ws + WS_WINT), MP, ZC_WLO, DM}; pg8::StaticOrder S; S.init(MP, ZC_WLO, F.G, F.bid);
    pg8::EpiIn E{(bf16_t*)(F.ws + WS_Z), F.out + O_KP, F.out + O_VP, (float*)(F.ws + WS_KMP), (const float*)(F.ws + WS_ROPE)};
    pg8::gemm_phase<pg8::EpiIn, pg8::StaticOrder, true, true>(F.lds, g, S, E);
    for (int u = F.bid; u < MP / 32; u += F.G) lora_unit(F, u);
    phase_inproj_sample(F);
}
__device__ __forceinline__ void phase2(Frame& F) {
    { int last_bh = -1; u32x4 pf[7];
      const int cq = F.tid & 255, rg = F.tid >> 8;
      int phys = 0;
      if (F.bid < 2048) { const int j = F.bid & 255, k = F.bid >> 8; wkv::st_fetch((const bf16_t*)(F.ws + WS_Z), (j >> 3) >> 4, (j >> 3) & 15, (j & 7) + 8 * k, F.tid, pf);
          const int uid0 = (j >> 3) * 64 + (j & 7) + 8 * k; phys = F.page_table[uid0 >> 1]; }
      for (int u = F.bid; u < 2048; u += F.G) { const int j = u & 255, k = u >> 8, bh = j >> 3, c = (j & 7) + 8 * k, uid = bh * 64 + c;
          const int un = u + F.G, jn = un & 255, kn = un >> 8, uidn = (jn >> 3) * 64 + (jn & 7) + 8 * kn;
          const int physn = (un < 2048) ? F.page_table[uidn >> 1] : 0;
          const float* kmsrc = F.cache_k + ((size_t)phys * PAGE + (uid & 1) * 64 + rg) * 1024 + cq * 4;
          float* kmdst = (float*)(F.ws + WS_KMS) + ((size_t)uid * 2 + rg) * 1024 + cq * 4;
          wkv::scanA_unit(F, bh, c, bh != last_bh, pf, jn >> 3, (jn & 7) + 8 * kn, un < 2048, kmsrc, kmdst); last_bh = bh; phys = physn; } }
    for (int u = F.bid; u < 240; u += F.G) moba_select_unit(F, u);
}
__device__ __forceinline__ void phase3(Frame& F) {
    moba_past_phase(F, F.G > 64 ? F.G - 64 : F.G);
    __syncthreads();
    for (int u = F.G - 1 - F.bid; u < 64; u += F.G) wkv::scanB_unit(F, u);
    for (int u = ((2 * F.G - 65 - F.bid) % F.G) * NWAVES + F.wave; u < 128; u += F.G * NWAVES) sample_wkv_unit(F, u, (LAS float*)F.lds + 4096 + F.wave * 512);
}
__device__ __forceinline__ void phase4(Frame& F) {
    for (int u = F.bid; u < 2048; u += F.G) wkv::scanC_unit(F, u >> 6, u & 63);
    for (int u = F.bid; u < 256; u += F.G) moba_own(F, u);
    for (int u = F.G - 1 - F.bid; u < 64; u += F.G) sample_attn_unit(F, u);
}
__device__ __forceinline__ void phase5(Frame& F) {
    { pg8::Gemm g{(const bf16_t*)(F.ws + WS_OA), (const bf16_t*)(F.ws + WS_PAT), MP, DM, DA}; pg8::StaticOrder S; S.init(MP, DM, F.G, F.bid);
      pg8::EpiMrgA E{(const bf16_t*)(F.ws + WS_Z), (bf16_t*)(F.ws + WS_TMP)};
      pg8::gemm_phase<pg8::EpiMrgA, pg8::StaticOrder, true, true>(F.lds, g, S, E); }
    { pg8::Gemm g{(const bf16_t*)(F.ws + WS_OB), (const bf16_t*)(F.ws + WS_PBT), MP, DM, DBB}; pg8::StaticOrder S; S.init(MP, DM, F.G, F.bid);
      pg8::EpiMrgB E{(const bf16_t*)(F.ws + WS_Z), (const bf16_t*)(F.ws + WS_TMP), (bf16_t*)(F.ws + WS_MRG)};
      pg8::gemm_phase<pg8::EpiMrgB, pg8::StaticOrder, true, true>(F.lds, g, S, E); }
    phase_merge_sample(F);
}
__device__ __forceinline__ void phase6(Frame& F) {
    pg8::Gemm g{(const bf16_t*)(F.ws + WS_MRG), (const bf16_t*)(F.ws + WS_WOT), MP, DM, DM}; pg8::StaticOrder S; S.init(MP, DM, F.G, F.bid);
    pg8::EpiRes E{F.x_p, F.out + O_YP};
    pg8::gemm_phase<pg8::EpiRes, pg8::StaticOrder, true, true>(F.lds, g, S, E);
    phase_out_sample(F);
}
__global__ void __launch_bounds__(NTHR, 2) fwd_kernel(Args args) {
    extern __shared__ __attribute__((aligned(16))) unsigned char lds[];
    Frame F;
    F.lds = (LAS unsigned char*)lds; F.ldsg = (char*)lds;
    F.tid = threadIdx.x; F.lane = F.tid & 63; F.wave = __builtin_amdgcn_readfirstlane(F.tid >> 6); F.G = gridDim.x; F.bid = blockIdx.x;
    F.x_p = (const float*)args.in[0]; F.x_s = (const float*)args.in[1]; F.st_shift = (const float*)args.in[2]; F.st_wkv = (const float*)args.in[3];
    F.cache_k = (const float*)args.in[4]; F.cache_v = (const float*)args.in[5]; F.page_table = (const int*)args.in[6];
    F.ln_w = (const float*)args.in[7]; F.w_in = (const float*)args.in[8]; F.mu = (const float*)args.in[9]; F.w0 = (const float*)args.in[10]; F.w2 = (const float*)args.in[11];
    F.a0 = (const float*)args.in[12]; F.a2 = (const float*)args.in[13]; F.k_k = (const float*)args.in[14]; F.k_a = (const float*)args.in[15]; F.r_k = (const float*)args.in[16];
    F.lnx_w = (const float*)args.in[17]; F.lnx_b = (const float*)args.in[18]; F.p_a = (const float*)args.in[19]; F.p_b = (const float*)args.in[20]; F.w_o = (const float*)args.in[21];
    F.final_w = (const float*)args.in[22]; F.out = args.out; F.ws = args.ws;
    volatile LAS unsigned* MISC = (volatile LAS unsigned*)(F.lds + MISC_OFF);
    for (int u = F.tid; u < (LDS_BYTES - LDSCTL_OFF) / 4; u += NTHR) ((LAS unsigned*)(F.lds + LDSCTL_OFF))[u] = 0u;
    __syncthreads();
    const int lo = args.ph_lo, hi = args.ph_hi;
    XcdBarrier bar; bar.bar = (unsigned*)(F.ws + WS_CTL) + CW_BAR; bar.x = 0; bar.st = MISC + 8;
    if (hi - lo > 1) bar = xcd_barrier_post((unsigned*)(F.ws + WS_CTL) + CW_BAR, MISC + 8);
#define IN(k) (lo <= (k) && (k) < hi)
#define SEAM(k) do { if (IN(k) && IN((k) + 1)) xcd_barrier(bar); } while (0)

    if (IN(0)) { phase_prologue(F); if (REP0 > 1) { xcd_barrier(bar); phase_prologue(F); } }
    SEAM(0);
    if (IN(1)) { phase1(F); if (REP1 > 1) { xcd_barrier(bar); phase1(F); } }
    SEAM(1);
    if (IN(2)) { phase2(F); if (REP2 > 1) { xcd_barrier(bar); phase2(F); } }
    SEAM(2);
    if (IN(3)) { phase3(F); if (REP3 > 1) { xcd_barrier(bar); phase3(F); } }
    SEAM(3);
    if (IN(4)) { phase4(F); if (REP4 > 1) { xcd_barrier(bar); phase4(F); } }
    SEAM(4);
    if (IN(5)) { phase5(F); if (REP5 > 1) { xcd_barrier(bar); phase5(F); } }
    SEAM(5);
    if (IN(6)) { phase6(F); if (REP6 > 1) { xcd_barrier(bar); phase6(F); } }
    SEAM(6);
    if (IN(7)) {
        for (int r = F.bid * NWAVES + F.wave; r < MP + DECB; r += F.G * NWAVES) final_norm_row(F, r < MP ? F.out + O_YP + (size_t)r * DM : F.out + O_YS + (size_t)(r - MP) * DM);
    }
#undef IN
#undef SEAM
}

extern "C" void kernel_launch(void* const* d_in, const int* in_sizes, int n_in, void* d_out, int out_size, void* d_ws, size_t ws_size, hipStream_t stream) {
    static int grid = 0;
    if (grid == 0) {
        if (n_in != 23 || (size_t)out_size != O_END || ws_size < WS_END) { fprintf(stderr, "kernel_launch: unexpected shapes: n_in %d out %d ws %zu; nothing launched\n", n_in, out_size, ws_size); grid = -1; return; }
        int dev = 0, cus = 0, per_cu = 0;
        if (hipGetDevice(&dev) != hipSuccess || hipDeviceGetAttribute(&cus, hipDeviceAttributeMultiprocessorCount, dev) != hipSuccess) { grid = -1; return; }
        if (hipFuncSetAttribute((const void*)fwd_kernel, hipFuncAttributeMaxDynamicSharedMemorySize, LDS_BYTES) != hipSuccess) { fprintf(stderr, "kernel_launch: hipFuncSetAttribute failed\n"); grid = -1; return; }
        if (hipOccupancyMaxActiveBlocksPerMultiprocessor(&per_cu, (const void*)fwd_kernel, NTHR, LDS_BYTES) != hipSuccess || per_cu < 1)
            fprintf(stderr, "kernel_launch: note: occupancy query reports %d workgroups per CU\n", per_cu);
        (void)hipGetLastError();
        grid = cus;
    }
    if (grid < 0) return;
    if (hipMemsetAsync((char*)d_ws + WS_CTL, 0, CTL_ZERO_BYTES, stream) != hipSuccess) { fprintf(stderr, "kernel_launch: memset failed\n"); return; }
    Args a{};
    for (int i = 0; i < 23; ++i) a.in[i] = d_in[i];
    a.out = (float*)d_out; a.ws = (unsigned char*)d_ws;
    constexpr int NL = MK_N_LAUNCHES;
    for (int li = 0; li < NL; ++li) {
        a.ph_lo = li * N_PHASES / NL; a.ph_hi = (li + 1) * N_PHASES / NL;
        hipLaunchKernelGGL(fwd_kernel, dim3(grid), dim3(NTHR), LDS_BYTES, stream, a);
        const hipError_t le = hipPeekAtLastError();
        if (le != hipSuccess) { fprintf(stderr, "kernel_launch: launch %d failed: %s\n", li, hipGetErrorName(le)); break; }
    }
}
```
